# Optimizing an MI355X kernel written in HIP

```python
import math
import jax, jax.numpy as jnp
from jax import lax
import numpy as np

D_MODEL = 1024
BATCH = 8
SEQ = 2048
DEPTH = 2

CHUNK = 64
NORM_EPS = 1e-6
FFN_HALF = 0.5
D_FF = 2816

A_HEAD_DIM = 64
A_WIDTH = D_MODEL // 2
A_HEADS = A_WIDTH // A_HEAD_DIM
W_LORA = 64
A_LORA = 64
G_LORA = 128
GN_EPS = 64e-5
A_PROJ = 3 * A_WIDTH + W_LORA + A_LORA + G_LORA
A_SPLITS = (A_WIDTH, 2 * A_WIDTH, 3 * A_WIDTH, 3 * A_WIDTH + W_LORA,
            3 * A_WIDTH + W_LORA + A_LORA)

B_WIDTH = D_MODEL // 2
B_BLOCKS = 8
B_BLOCK_DIM = B_WIDTH // B_BLOCKS
CONV_WIDTH = 4
LRU_C = 8.0

IN_PROJ = A_PROJ + 2 * B_WIDTH

C_HEAD_DIM = 64
C_HEADS = D_MODEL // C_HEAD_DIM
C_WIDTH = C_HEADS * C_HEAD_DIM
Q_BLOCK = 128

kernel_name = "hybrid_rwkv7_rglru_stickbreaking_macaron"


def rmsnorm(x, g):
    xf = x.astype(jnp.float32)
    y = xf * lax.rsqrt(jnp.mean(xf * xf, axis=-1, keepdims=True) + NORM_EPS)
    return (y * g.astype(jnp.float32)).astype(x.dtype)


def swiglu(x, w_in, w_out):
    gate, up = jnp.split(x @ w_in, 2, axis=-1)
    return (jax.nn.silu(gate) * up) @ w_out


def shift_right(x):
    return jnp.pad(x, ((0, 0), (1, 0), (0, 0)))[:, :-1]


def rwkv7_step(S, inp):
    r_t, w_t, k_t, v_t, kk_t, a_t = inp
    sa = jnp.einsum("bhvk,bhk->bhv", S, -kk_t)
    S = (S * w_t[:, :, None, :]
         + jnp.einsum("bhv,bhk->bhvk", sa, kk_t * a_t)
         + jnp.einsum("bhv,bhk->bhvk", v_t, k_t))
    y = jnp.einsum("bhvk,bhk->bhv", S, r_t)
    return S, y


def rwkv7_time_mix(pa, mu, w0, w2, a0, a2, g2, k_k, k_a, r_k, lnx_g, lnx_b):
    bsz, seqlen, _ = pa.shape
    dt = pa.dtype
    f32 = jnp.float32
    pa = pa + mu * (shift_right(pa) - pa)
    r, k, v, w_lo, a_lo, g_lo = jnp.split(pa, A_SPLITS, axis=-1)
    w_log = -jax.nn.softplus(-(w0 + jnp.tanh(w_lo) @ w2).astype(f32)) - 0.5
    decay = jnp.exp(-jnp.exp(w_log))
    a = jax.nn.sigmoid((a0 + a_lo @ a2).astype(f32))
    g = jax.nn.sigmoid(g_lo) @ g2

    def heads(t):
        return t.astype(f32).reshape(bsz, seqlen, A_HEADS, A_HEAD_DIM)

    kk = heads(k * k_k)
    kk = kk / jnp.maximum(jnp.sqrt(jnp.sum(kk * kk, axis=-1, keepdims=True)), 1e-12)
    a_h = heads(a)
    k_h = heads(k) * (1.0 + (a_h - 1.0) * k_a.astype(f32).reshape(A_HEADS, A_HEAD_DIM))
    r_h, v_h, w_h = heads(r), heads(v), heads(decay)

    S0 = jnp.zeros((bsz, A_HEADS, A_HEAD_DIM, A_HEAD_DIM), f32)
    xs = tuple(jnp.moveaxis(t, 1, 0) for t in (r_h, w_h, k_h, v_h, kk, a_h))
    _, y = lax.scan(rwkv7_step, S0, xs)
    y = jnp.moveaxis(y, 0, 1)

    mean = jnp.mean(y, axis=-1, keepdims=True)
    var = jnp.mean(jnp.square(y - mean), axis=-1, keepdims=True)
    yn = (y - mean) * lax.rsqrt(var + GN_EPS)
    yn = (yn * lnx_g.astype(f32).reshape(A_HEADS, A_HEAD_DIM)
          + lnx_b.astype(f32).reshape(A_HEADS, A_HEAD_DIM))
    bonus = jnp.sum(r_h * k_h * r_k.astype(f32), axis=-1, keepdims=True) * v_h
    return (yn + bonus).reshape(bsz, seqlen, A_WIDTH).astype(dt) * g


def lru_combine(c1, c2):
    a1, b1 = c1
    a2, b2 = c2
    return a1 * a2, a2 * b1 + b2


def rglru_mix(xb, gb, conv_w, conv_b, gate_a_w, gate_a_b, gate_x_w, gate_x_b, lam):
    bsz, seqlen, _ = xb.shape
    f32 = jnp.float32
    xp = jnp.pad(xb, ((0, 0), (CONV_WIDTH - 1, 0), (0, 0)))
    xc = conv_b + sum(xp[:, i:i + seqlen] * conv_w[i] for i in range(CONV_WIDTH))
    blocks = xc.reshape(bsz, seqlen, B_BLOCKS, B_BLOCK_DIM)
    r = jax.nn.sigmoid((jnp.einsum("btni,nij->btnj", blocks, gate_a_w)
                        .reshape(bsz, seqlen, B_WIDTH) + gate_a_b).astype(f32))
    i_g = jax.nn.sigmoid((jnp.einsum("btni,nij->btnj", blocks, gate_x_w)
                          .reshape(bsz, seqlen, B_WIDTH) + gate_x_b).astype(f32))
    log_a = -LRU_C * r * jax.nn.softplus(-lam.astype(f32))
    a = jnp.exp(log_a)
    mult = jnp.sqrt(-jnp.expm1(2.0 * log_a))
    u = mult * i_g * xc.astype(f32)
    _, h = lax.associative_scan(lru_combine, (a, u), axis=1)
    return h.astype(xb.dtype) * jax.nn.gelu(gb)


def even_mixer(h, w_in, mu, w0, w2, a0, a2, g2, k_k, k_a, r_k, lnx_g, lnx_b,
               conv_w, conv_b, gate_a_w, gate_a_b, gate_x_w, gate_x_b, lam, w_out):
    proj = h @ w_in
    pa, xb, gb = jnp.split(proj, (A_PROJ, A_PROJ + B_WIDTH), axis=-1)
    ya = rwkv7_time_mix(pa, mu, w0, w2, a0, a2, g2, k_k, k_a, r_k, lnx_g, lnx_b)
    yb = rglru_mix(xb, gb, conv_w, conv_b, gate_a_w, gate_a_b, gate_x_w, gate_x_b, lam)
    return jnp.concatenate([ya, yb], axis=-1) @ w_out


def stick_breaking_mixer(h, w_qkv, w_out):
    bsz, seqlen, _ = h.shape
    q, k, v = jnp.split(h @ w_qkv, 3, axis=-1)
    q = q.reshape(bsz, seqlen, C_HEADS, C_HEAD_DIM)
    k = k.reshape(bsz, seqlen, C_HEADS, C_HEAD_DIM)
    v = v.reshape(bsz, seqlen, C_HEADS, C_HEAD_DIM)
    scale = 1.0 / math.sqrt(C_HEAD_DIM)
    outs = []
    for s0 in range(0, seqlen, Q_BLOCK):
        end = s0 + Q_BLOCK
        qb, kb, vb = q[:, s0:end], k[:, :end], v[:, :end]
        z = jnp.einsum("bqhd,bkhd->bhqk", qb, kb).astype(jnp.float32) * scale
        q_pos = s0 + jnp.arange(Q_BLOCK)
        k_pos = jnp.arange(end)
        mask = k_pos[None, :] < q_pos[:, None]
        log_1m = jnp.where(mask, jax.nn.log_sigmoid(-z), 0.0)
        between = lax.cumsum(log_1m, axis=3, reverse=True) - log_1m
        att = jnp.where(mask, jnp.exp(jax.nn.log_sigmoid(z) + between), 0.0)
        outs.append(jnp.einsum("bhqk,bkhd->bqhd", att.astype(vb.dtype), vb))
    o = jnp.concatenate(outs, axis=1).reshape(bsz, seqlen, C_WIDTH)
    return o @ w_out


def macaron_layer(x, mixer, ffn1_pre_g, ffn1_post_g, ffn1_w_in, ffn1_w_out,
                  mix_pre_g, mix_post_g, ffn2_pre_g, ffn2_post_g, ffn2_w_in, ffn2_w_out):
    x = x + FFN_HALF * rmsnorm(swiglu(rmsnorm(x, ffn1_pre_g), ffn1_w_in, ffn1_w_out), ffn1_post_g)
    x = x + rmsnorm(mixer(rmsnorm(x, mix_pre_g)), mix_post_g)
    x = x + FFN_HALF * rmsnorm(swiglu(rmsnorm(x, ffn2_pre_g), ffn2_w_in, ffn2_w_out), ffn2_post_g)
    return x


def setup_inputs(seed: int = 0) -> dict:
    key = jax.random.key(seed)
    keys = iter(jax.random.split(key, 64))
    f32 = jnp.float32

    def nrm(shape, scale):
        return scale * jax.random.normal(next(keys), shape, f32)

    def gain(n):
        return 1.0 + nrm((n,), 0.05)

    def ffn_params(prefix, d):
        d[prefix + "_pre_g"] = gain(D_MODEL)
        d[prefix + "_post_g"] = gain(D_MODEL)
        d[prefix + "_w_in"] = nrm((D_MODEL, 2 * D_FF), D_MODEL ** -0.5)
        d[prefix + "_w_out"] = nrm((D_FF, D_MODEL), D_FF ** -0.5)

    d = {"x": nrm((BATCH, SEQ, D_MODEL), 1.0)}
    ffn_params("l0_ffn1", d)
    d["l0_mix_pre_g"] = gain(D_MODEL)
    d["l0_mix_post_g"] = gain(D_MODEL)
    d["l0_w_in"] = nrm((D_MODEL, IN_PROJ), D_MODEL ** -0.5)
    d["l0_mu"] = jax.random.uniform(next(keys), (A_PROJ,), f32, 0.0, 1.0)
    d["l0_w0"] = jnp.linspace(-6.0, -1.0, A_WIDTH, dtype=f32) + nrm((A_WIDTH,), 0.1)
    d["l0_w2"] = nrm((W_LORA, A_WIDTH), 0.1)
    d["l0_a0"] = nrm((A_WIDTH,), 0.1)
    d["l0_a2"] = nrm((A_LORA, A_WIDTH), A_LORA ** -0.5)
    d["l0_g2"] = nrm((G_LORA, A_WIDTH), G_LORA ** -0.5)
    d["l0_k_k"] = 0.85 + nrm((A_WIDTH,), 0.02)
    d["l0_k_a"] = 1.0 + nrm((A_WIDTH,), 0.02)
    d["l0_r_k"] = nrm((A_HEADS, A_HEAD_DIM), 0.1)
    d["l0_lnx_g"] = gain(A_WIDTH)
    d["l0_lnx_b"] = nrm((A_WIDTH,), 0.02)
    d["l0_conv_w"] = nrm((CONV_WIDTH, B_WIDTH), CONV_WIDTH ** -0.5)
    d["l0_conv_b"] = nrm((B_WIDTH,), 0.02)
    d["l0_gate_a_w"] = nrm((B_BLOCKS, B_BLOCK_DIM, B_BLOCK_DIM), B_BLOCK_DIM ** -0.5)
    d["l0_gate_a_b"] = nrm((B_WIDTH,), 0.02)
    d["l0_gate_x_w"] = nrm((B_BLOCKS, B_BLOCK_DIM, B_BLOCK_DIM), B_BLOCK_DIM ** -0.5)
    d["l0_gate_x_b"] = nrm((B_WIDTH,), 0.02)
    a_pow = jax.random.uniform(next(keys), (B_WIDTH,), f32, 0.9, 0.999) ** (1.0 / LRU_C)
    d["l0_lambda"] = jnp.log(a_pow) - jnp.log1p(-a_pow)
    d["l0_w_out"] = nrm((A_WIDTH + B_WIDTH, D_MODEL), (A_WIDTH + B_WIDTH) ** -0.5)
    ffn_params("l0_ffn2", d)
    ffn_params("l1_ffn1", d)
    d["l1_mix_pre_g"] = gain(D_MODEL)
    d["l1_mix_post_g"] = gain(D_MODEL)
    d["l1_w_qkv"] = nrm((D_MODEL, 3 * C_WIDTH), D_MODEL ** -0.5)
    d["l1_w_out"] = nrm((C_WIDTH, D_MODEL), C_WIDTH ** -0.5)
    ffn_params("l1_ffn2", d)
    return d


def reference(x,
              l0_ffn1_pre_g, l0_ffn1_post_g, l0_ffn1_w_in, l0_ffn1_w_out,
              l0_mix_pre_g, l0_mix_post_g, l0_w_in, l0_mu, l0_w0, l0_w2, l0_a0, l0_a2,
              l0_g2, l0_k_k, l0_k_a, l0_r_k, l0_lnx_g, l0_lnx_b, l0_conv_w, l0_conv_b,
              l0_gate_a_w, l0_gate_a_b, l0_gate_x_w, l0_gate_x_b, l0_lambda, l0_w_out,
              l0_ffn2_pre_g, l0_ffn2_post_g, l0_ffn2_w_in, l0_ffn2_w_out,
              l1_ffn1_pre_g, l1_ffn1_post_g, l1_ffn1_w_in, l1_ffn1_w_out,
              l1_mix_pre_g, l1_mix_post_g, l1_w_qkv, l1_w_out,
              l1_ffn2_pre_g, l1_ffn2_post_g, l1_ffn2_w_in, l1_ffn2_w_out):
    def layer0(t):
        mixer = lambda h: even_mixer(h, l0_w_in, l0_mu, l0_w0, l0_w2, l0_a0, l0_a2, l0_g2,
                                     l0_k_k, l0_k_a, l0_r_k, l0_lnx_g, l0_lnx_b,
                                     l0_conv_w, l0_conv_b, l0_gate_a_w, l0_gate_a_b,
                                     l0_gate_x_w, l0_gate_x_b, l0_lambda, l0_w_out)
        return macaron_layer(t, mixer, l0_ffn1_pre_g, l0_ffn1_post_g, l0_ffn1_w_in, l0_ffn1_w_out,
                             l0_mix_pre_g, l0_mix_post_g,
                             l0_ffn2_pre_g, l0_ffn2_post_g, l0_ffn2_w_in, l0_ffn2_w_out)

    def layer1(t):
        mixer = lambda h: stick_breaking_mixer(h, l1_w_qkv, l1_w_out)
        return macaron_layer(t, mixer, l1_ffn1_pre_g, l1_ffn1_post_g, l1_ffn1_w_in, l1_ffn1_w_out,
                             l1_mix_pre_g, l1_mix_post_g,
                             l1_ffn2_pre_g, l1_ffn2_post_g, l1_ffn2_w_in, l1_ffn2_w_out)

    layers = [layer0, layer1]
    for i in range(DEPTH):
        x = layers[i](x)
    return x
```

```cpp
#include <hip/hip_runtime.h>
#include <hip/hip_cooperative_groups.h>
#include <cstdio>
#include <cstdint>
namespace pg8 {
#define PG8_LAS __attribute__((address_space(3)))
typedef unsigned short bf16_t;
typedef short bf16x8 __attribute__((ext_vector_type(8)));
typedef float f32x4 __attribute__((ext_vector_type(4)));
typedef unsigned u32x4 __attribute__((ext_vector_type(4)));
constexpr int BM = 256, BK = 64, HALF = 128, HTB = HALF * BK * 2  , STAGE_BYTES = 8 * HTB, NXCD = 8, WGM = 8;

__host__ __device__ __forceinline__ int lds_byte(int r, int c) { const int st = (r >> 4) * 2 + (c >> 5), rr = r & 15, cc = c & 31, ob = rr * 64 + cc * 2; return st * 1024 + (ob ^ (((ob >> 9) & 1) << 5)); }
__host__ __device__ __forceinline__ void stage_rc(int b, int& R, int& C) { const int st = b / 1024, sb = b % 1024, swz = sb ^ (((sb >> 9) & 1) << 5); R = (st >> 1) * 16 + swz / 64; C = (st & 1) * 32 + (swz % 64) / 2; }
__host__ __device__ __forceinline__ int perm32(int rho) { const int n = rho >> 4, i = rho & 15; return 8 * (i >> 2) + 4 * n + (i & 3); }

struct Unit { int pm, pn; };
struct Gemm { const bf16_t* A; const bf16_t* Bt; int M, N, K; };

struct StaticOrder {
    int nM, nN, nwg, G, c;
    __host__ __device__ void init(int M, int N, int G_, int c_) { nM = M / BM; nN = N / BM; nwg = nM * nN; G = G_; c = c_; }
    __host__ __device__ bool next(int i, Unit& u) const {
        const long L = (long)i * G + c; if (L >= nwg) return false;
        int wgid = (int)L; { const int q = nwg / NXCD, r = nwg % NXCD, xcd = wgid % NXCD, off = wgid / NXCD; wgid = (xcd < r ? xcd * (q + 1) : r * (q + 1) + (xcd - r) * q) + off; }
        const int nig = WGM * nN, gid = wgid / nig, fm = gid * WGM, gsz = (nM - fm) < WGM ? (nM - fm) : WGM;
        u.pm = fm + ((wgid % nig) % gsz); u.pn = (wgid % nig) / gsz; return true;
    }
    __device__ __forceinline__ void a_ready(const Unit&) const {}
    __device__ __forceinline__ void done(const Unit&) const {}
};

__device__ __forceinline__ unsigned cvt_pk_bf16(float lo, float hi) { unsigned r; asm volatile("v_cvt_pk_bf16_f32 %0, %1, %2" : "=v"(r) : "v"(lo), "v"(hi)); return r; }
typedef float f32x2 __attribute__((ext_vector_type(2)));
__device__ __forceinline__ f32x2 gelu_pk(f32x2 v) {
    const f32x2 av = __builtin_elementwise_abs(v), d = av * 0.2316418882f + 1.0f;
    f32x2 t; t.x = __builtin_amdgcn_rcpf(d.x); t.y = __builtin_amdgcn_rcpf(d.y);
    f32x2 q = t * 0.5307027145f + (-0.7265760135f); q = q * t + 0.7107068705f; q = q * t + (-0.142248368f); q = q * t + 0.127414796f; q = q * t;
    const f32x2 s = (v * v) * (-0.72134752044f);
    f32x2 e; e.x = __builtin_amdgcn_exp2f(s.x); e.y = __builtin_amdgcn_exp2f(s.y);
    const f32x2 m = v * (q * e), r = v - m;
    f32x2 o; o.x = v.x < 0.f ? m.x : r.x; o.y = v.y < 0.f ? m.y : r.y; return o;
}

template <int ACT  > struct EpiBf16 {
    static constexpr bool PERM = true, AFTER_DRAIN = false; static_assert(ACT == 0 || ACT == 1, "EpiBf16: ACT is 0 (none) or 1 (gelu_pk)");
    bf16_t* O; int ldc; const float* bias; int split_cols; size_t split_stride; float scale0;
    __device__ __forceinline__ void operator()(const f32x4 (&acc)[2][2][4][2], const Unit& u, int wr, int wc, int fr, int fq) const {
        const int row0 = u.pm * BM + wr * 64 + fr; int colt = u.pn * BM; bf16_t* base = O;
        float sc = 1.f; if (split_cols) { const int t = colt / split_cols; base += (size_t)t * split_stride; colt -= t * split_cols; if (t == 0) sc = scale0; }
        const int col0 = colt + wc * 32 + 8 * fq, bcol0 = u.pn * BM + wc * 32 + 8 * fq;
        f32x4 bv[2][2];
#pragma unroll
        for (int bj = 0; bj < 2; ++bj)
#pragma unroll
            for (int n = 0; n < 2; ++n) bv[bj][n] = bias ? *(const f32x4*)(bias + bcol0 + bj * HALF + 4 * n) : (f32x4){0.f, 0.f, 0.f, 0.f};
#pragma unroll
        for (int ai = 0; ai < 2; ++ai)
#pragma unroll
            for (int m = 0; m < 4; ++m) { bf16_t* rowp = base + (size_t)(row0 + ai * HALF + m * 16) * ldc + col0;
#pragma unroll
                for (int bj = 0; bj < 2; ++bj) { f32x4 v0 = acc[ai][bj][m][0] + bv[bj][0], v1 = acc[ai][bj][m][1] + bv[bj][1];
                    if (ACT == 1) { f32x2 a = gelu_pk((f32x2){v0[0], v0[1]}), b = gelu_pk((f32x2){v0[2], v0[3]}), c = gelu_pk((f32x2){v1[0], v1[1]}), d = gelu_pk((f32x2){v1[2], v1[3]});
                        v0 = (f32x4){a.x, a.y, b.x, b.y}; v1 = (f32x4){c.x, c.y, d.x, d.y}; }
                    v0 = v0 * sc; v1 = v1 * sc; u32x4 w; w.x = cvt_pk_bf16(v0[0], v0[1]); w.y = cvt_pk_bf16(v0[2], v0[3]); w.z = cvt_pk_bf16(v1[0], v1[1]); w.w = cvt_pk_bf16(v1[2], v1[3]);
                    *(u32x4*)(rowp + bj * HALF) = w; } }
    }
};

struct PanelStats {
    unsigned* xbuf;
    unsigned* cnt;
    unsigned* tmo;
    int ntn; float eps;
    unsigned code;
    __device__ __forceinline__ bool run(const f32x4 (&v)[2][2][4][2], const Unit& u, int wr, int wc, int fr, int fq, PG8_LAS unsigned char* lds, int wid, int lane) const {
        typedef float f32x2v __attribute__((ext_vector_type(2)));
        PG8_LAS f32x2v* P = (PG8_LAS f32x2v*)lds;
        PG8_LAS f32x2v* S = (PG8_LAS f32x2v*)(lds + 8192);
        PG8_LAS unsigned* flag = (PG8_LAS unsigned*)(lds + 8192 + 2048);
#pragma unroll
        for (int ai = 0; ai < 2; ++ai)
#pragma unroll
            for (int m = 0; m < 4; ++m) {
                float s = 0.f;
#pragma unroll
                for (int bj = 0; bj < 2; ++bj)
#pragma unroll
                    for (int n = 0; n < 2; ++n) { const f32x4 x = v[ai][bj][m][n]; s += (x[0] + x[1]) + (x[2] + x[3]); }
                s += __shfl_xor(s, 16); s += __shfl_xor(s, 32);
                const float mw = s * (1.0f / 64.0f); float q = 0.f;
#pragma unroll
                for (int bj = 0; bj < 2; ++bj)
#pragma unroll
                    for (int n = 0; n < 2; ++n) { const f32x4 d = v[ai][bj][m][n] - mw; q += (d[0] * d[0] + d[1] * d[1]) + (d[2] * d[2] + d[3] * d[3]); }
                q += __shfl_xor(q, 16); q += __shfl_xor(q, 32);
                if (fq == 0) P[(ai * HALF + wr * 64 + m * 16 + fr) * 4 + wc] = (f32x2v){mw, q};
            }
        asm volatile("s_waitcnt lgkmcnt(0)" ::: "memory"); __builtin_amdgcn_s_barrier(); asm volatile("" ::: "memory");
#if defined(BROKEN_EXCHANGE_NO_WAIT)
#warning BROKEN CONTROL BUILD: the row-statistics exchange does not wait; results are wrong by design
        if (blockIdx.x >= 64) { const long long t0_ = clock64(); while (clock64() - t0_ < 60000) __builtin_amdgcn_s_sleep(8); }
#endif
        const int row = wid * 32 + (lane & 31);
        if (lane < 32) {
            const f32x2v a = P[row * 4 + 0], b = P[row * 4 + 1], c = P[row * 4 + 2], d = P[row * 4 + 3];
            const float mt = (a.x + b.x + c.x + d.x) * 0.25f;
            const float da = a.x - mt, db = b.x - mt, dc = c.x - mt, dd = d.x - mt;
            const float m2 = (a.y + b.y) + (c.y + d.y) + 64.0f * ((da * da + db * db) + (dc * dc + dd * dd));
            unsigned long long* slot = (unsigned long long*)xbuf + ((size_t)(u.pm * BM + row) * 4 + u.pn);
            __hip_atomic_store(slot, ((unsigned long long)__float_as_uint(m2) << 32) | __float_as_uint(mt), __ATOMIC_RELAXED, __HIP_MEMORY_SCOPE_AGENT);
        }
        asm volatile("s_waitcnt vmcnt(0)" ::: "memory");
        if (lane == 0) __hip_atomic_fetch_add(cnt + 64 * u.pm, 1u, __ATOMIC_RELAXED, __HIP_MEMORY_SCOPE_AGENT);
        if (wid == 0) {
            bool dead = false; const unsigned long long t0 = __builtin_amdgcn_s_memrealtime(); const unsigned want = 8u * (unsigned)ntn;
            for (;;) {
#if defined(BROKEN_EXCHANGE_NO_WAIT)
                break;
#endif
                if ((unsigned)__builtin_amdgcn_readfirstlane(__hip_atomic_load(cnt + 64 * u.pm, __ATOMIC_RELAXED, __HIP_MEMORY_SCOPE_AGENT)) >= want) break;
                if (__builtin_amdgcn_s_memrealtime() - t0 > 2000000ull) {
                    if (lane == 0) { unsigned expect = 0u; __hip_atomic_compare_exchange_strong(tmo + 1, &expect, code | (unsigned)(u.pm & 0xff), __ATOMIC_RELAXED, __ATOMIC_RELAXED, __HIP_MEMORY_SCOPE_AGENT);
                                     __hip_atomic_store(tmo, 1u, __ATOMIC_RELAXED, __HIP_MEMORY_SCOPE_AGENT); }
                    dead = true; break; }
                __builtin_amdgcn_s_sleep(2);
            }
            __builtin_amdgcn_fence(__ATOMIC_ACQUIRE, "agent");
            if (lane == 0) flag[0] = dead ? 1u : 0u;
        }
        asm volatile("s_waitcnt vmcnt(0) lgkmcnt(0)" ::: "memory"); __builtin_amdgcn_s_barrier(); asm volatile("" ::: "memory");
        const bool bad = flag[0] != 0u;
        if (lane < 32) {
            const unsigned long long* slot = (const unsigned long long*)xbuf + (size_t)(u.pm * BM + row) * 4; float mt[4], m2[4]; float ms = 0.f;
#pragma unroll
            for (int t = 0; t < 4; ++t) { if (t < ntn) { const unsigned long long w = __hip_atomic_load(slot + t, __ATOMIC_RELAXED, __HIP_MEMORY_SCOPE_AGENT); mt[t] = __uint_as_float((unsigned)w); m2[t] = __uint_as_float((unsigned)(w >> 32)); } else { mt[t] = 0.f; m2[t] = 0.f; } ms += mt[t]; }
            const float mean = ms / (float)ntn; float q = 0.f;
#pragma unroll
            for (int t = 0; t < 4; ++t) if (t < ntn) { const float dm = mt[t] - mean; q += m2[t] + 256.0f * dm * dm; }
            S[row] = (f32x2v){mean, 1.0f / sqrtf(q / (256.0f * (float)ntn) + eps)};
        }
        asm volatile("s_waitcnt lgkmcnt(0)" ::: "memory"); __builtin_amdgcn_s_barrier(); asm volatile("" ::: "memory");
        return bad;
    }
};
struct EpiLnRes {
    static constexpr bool PERM = false, AFTER_DRAIN = true;
    const float* base; float* out; int ldc; const float* bias; PanelStats st; unsigned poison;
    __device__ __forceinline__ void fused(f32x4 (&acc)[2][2][4][2], const Unit& u, int wr, int wc, int fr, int fq, PG8_LAS unsigned char* lds, int wid, int lane) const {
        typedef float f32x2v __attribute__((ext_vector_type(2)));
        const PG8_LAS f32x2v* S = (const PG8_LAS f32x2v*)(lds + 8192);
        const int col0 = u.pn * BM + wc * 32 + 4 * fq;
#pragma unroll
        for (int bj = 0; bj < 2; ++bj)
#pragma unroll
            for (int n = 0; n < 2; ++n) { const f32x4 bv = bias ? *(const f32x4*)(bias + col0 + bj * HALF + n * 16) : (f32x4){0.f, 0.f, 0.f, 0.f};
#pragma unroll
                for (int ai = 0; ai < 2; ++ai)
#pragma unroll
                    for (int m = 0; m < 4; ++m) acc[ai][bj][m][n] += bv; }
        f32x4 pre[4][2][2];
#pragma unroll
        for (int m = 0; m < 4; ++m) { const size_t off = (size_t)(u.pm * BM + wr * 64 + m * 16 + fr) * ldc + col0;
#pragma unroll
            for (int bj = 0; bj < 2; ++bj)
#pragma unroll
                for (int n = 0; n < 2; ++n) pre[m][bj][n] = *(const f32x4*)(base + off + bj * HALF + n * 16); }
        const bool bad = st.run(acc, u, wr, wc, fr, fq, lds, wid, lane) || poison != 0u;
        const float qnan = __builtin_nanf("");
#pragma unroll
        for (int ai = 0; ai < 2; ++ai)
#pragma unroll
            for (int m = 0; m < 4; ++m) { const int r = ai * HALF + wr * 64 + m * 16 + fr; const f32x2v sr = S[r]; const size_t off = (size_t)(u.pm * BM + r) * ldc + col0;
#pragma unroll
                for (int bj = 0; bj < 2; ++bj)
#pragma unroll
                    for (int n = 0; n < 2; ++n) { const f32x4 bs = ai == 0 ? pre[m][bj][n] : *(const f32x4*)(base + off + bj * HALF + n * 16); f32x4 o = bs + (acc[ai][bj][m][n] - sr.x) * sr.y;
                        if (bad) o = (f32x4){qnan, qnan, qnan, qnan}; *(f32x4*)(out + off + bj * HALF + n * 16) = o; }
                if (m & 1) asm volatile("" ::: "memory"); }
    }
};
struct EpiLnResLn {
    static constexpr bool PERM = false, AFTER_DRAIN = true;
    const float* base; float* out; bf16_t* xn; int ldc; const float* bias; PanelStats st1, st2; unsigned poison;
    __device__ __forceinline__ void fused(f32x4 (&acc)[2][2][4][2], const Unit& u, int wr, int wc, int fr, int fq, PG8_LAS unsigned char* lds, int wid, int lane) const {
        typedef float f32x2v __attribute__((ext_vector_type(2))); typedef unsigned u32x2v __attribute__((ext_vector_type(2)));
        const PG8_LAS f32x2v* S = (const PG8_LAS f32x2v*)(lds + 8192);
        const int col0 = u.pn * BM + wc * 32 + 4 * fq;
#pragma unroll
        for (int bj = 0; bj < 2; ++bj)
#pragma unroll
            for (int n = 0; n < 2; ++n) { const f32x4 bv = bias ? *(const f32x4*)(bias + col0 + bj * HALF + n * 16) : (f32x4){0.f, 0.f, 0.f, 0.f};
#pragma unroll
                for (int ai = 0; ai < 2; ++ai)
#pragma unroll
                    for (int m = 0; m < 4; ++m) acc[ai][bj][m][n] += bv; }
        bool bad = st1.run(acc, u, wr, wc, fr, fq, lds, wid, lane) || poison != 0u;
        const float qnan = __builtin_nanf("");
#pragma unroll
        for (int ai = 0; ai < 2; ++ai)
#pragma unroll
            for (int m = 0; m < 4; ++m) { const int r = ai * HALF + wr * 64 + m * 16 + fr; const f32x2v sr = S[r]; const size_t off = (size_t)(u.pm * BM + r) * ldc + col0;
#pragma unroll
                for (int bj = 0; bj < 2; ++bj)
#pragma unroll
                    for (int n = 0; n < 2; ++n) { const f32x4 bs = *(const f32x4*)(base + off + bj * HALF + n * 16); acc[ai][bj][m][n] = bs + (acc[ai][bj][m][n] - sr.x) * sr.y; }
                asm volatile("" : "+v"(acc[ai][0][m][0]), "+v"(acc[ai][0][m][1]), "+v"(acc[ai][1][m][0]), "+v"(acc[ai][1][m][1]));
                if (m & 1) asm volatile("" ::: "memory"); }
        const bool bad1 = bad;
        bad = st2.run(acc, u, wr, wc, fr, fq, lds, wid, lane) || bad;
#pragma unroll
        for (int ai = 0; ai < 2; ++ai)
#pragma unroll
            for (int m = 0; m < 4; ++m) { const int r = ai * HALF + wr * 64 + m * 16 + fr; const f32x2v sr = S[r]; const size_t off = (size_t)(u.pm * BM + r) * ldc + col0;
#pragma unroll
                for (int bj = 0; bj < 2; ++bj)
#pragma unroll
                    for (int n = 0; n < 2; ++n) { const f32x4 x1 = acc[ai][bj][m][n]; *(f32x4*)(out + off + bj * HALF + n * 16) = bad1 ? (f32x4){qnan, qnan, qnan, qnan} : x1;
                        const f32x4 o = (x1 - sr.x) * sr.y; u32x2v w; w.x = cvt_pk_bf16(o[0], o[1]); w.y = cvt_pk_bf16(o[2], o[3]);
                        if (bad) { w.x = 0x7fc07fc0u; w.y = 0x7fc07fc0u; } *(u32x2v*)(xn + off + bj * HALF + n * 16) = w; }
                asm volatile("" ::: "memory"); }
    }
};

template <class Epi, class Sched, bool ALIGN_EPI = false, bool SP2 = false>
__device__ __forceinline__ void gemm_phase(PG8_LAS unsigned char* lds, const Gemm g, const Sched& S, const Epi& E) {
    const int tid = threadIdx.x, wid = __builtin_amdgcn_readfirstlane(tid >> 6), lane = tid & 63, wr = wid >> 2, wc = wid & 3, fr = lane & 15, fq = lane >> 4;
    const int K = g.K, nt = K / BK;
    unsigned voffA[2], voffB[2];
#pragma unroll
    for (int i = 0; i < 2; ++i) { int R, C; stage_rc(tid * 16 + i * 8192, R, C); const int Rb = Epi::PERM ? ((R & ~31) + perm32(R & 31)) : R;
        voffA[i] = (unsigned)(R * K + C) * 2u; voffB[i] = (unsigned)(Rb * K + C) * 2u; }
    const size_t kstep = (size_t)(BK * 2);
    const size_t hstep = (size_t)HALF * K * 2;
    const size_t tstep = 2 * hstep;
    const unsigned ldsw = (unsigned)wid * 1024u;
    const int aoff = lds_byte(wr * 64 + fr, fq * 8), boff = lds_byte(wc * 32 + fr, fq * 8);
#define PG8_SA(b, h) (((b) * 2 + (h)) * HTB)
#define PG8_SB(b, h) ((4 + (b) * 2 + (h)) * HTB)
#define PG8_STAGE(bufoff, gbase, voff) do { _Pragma("unroll") for (int _i = 0; _i < 2; ++_i) \
        __builtin_amdgcn_global_load_lds((const unsigned*)((const char*)(gbase) + (voff)[_i]), (PG8_LAS unsigned*)(lds + (bufoff) + ldsw + _i * 8192), 16, 0, 0); } while (0)
#define PG8_LDA(dst, b, h) do { _Pragma("unroll") for (int m = 0; m < 4; ++m) _Pragma("unroll") for (int k = 0; k < 2; ++k) dst[m][k] = *(const PG8_LAS bf16x8*)(lds + PG8_SA(b, h) + aoff + m * 2048 + k * 1024); } while (0)
#define PG8_LDB(dst, b, h) do { _Pragma("unroll") for (int n = 0; n < 2; ++n) _Pragma("unroll") for (int k = 0; k < 2; ++k) dst[n][k] = *(const PG8_LAS bf16x8*)(lds + PG8_SB(b, h) + boff + n * 2048 + k * 1024); } while (0)
#define PG8_MMA(ai, bj, At, Bt) do { __builtin_amdgcn_s_setprio(1); _Pragma("unroll") for (int m = 0; m < 4; ++m) _Pragma("unroll") for (int n = 0; n < 2; ++n) _Pragma("unroll") for (int k = 0; k < 2; ++k) \
        acc[ai][bj][m][n] = __builtin_amdgcn_mfma_f32_16x16x32_bf16(Bt[n][k], At[m][k], acc[ai][bj][m][n], 0, 0, 0); __builtin_amdgcn_s_setprio(0); } while (0)
#define PG8_WAIT_V(n) asm volatile("s_waitcnt vmcnt(" #n ")" ::: "memory")
#define PG8_WAIT_L(n) asm volatile("s_waitcnt lgkmcnt(" #n ")" ::: "memory")
#define PG8_BAR __builtin_amdgcn_s_barrier()
#define PG8_SCHED __builtin_amdgcn_sched_barrier(0)
    Unit cur, nxt; int ui = 0;
    if (!S.next(0, cur)) return;
    f32x4 acc[2][2][4][2];
#pragma unroll
    for (int a = 0; a < 2; ++a)
#pragma unroll
        for (int b = 0; b < 2; ++b)
#pragma unroll
            for (int m = 0; m < 4; ++m)
#pragma unroll
                for (int n = 0; n < 2; ++n) acc[a][b][m][n] = (f32x4){0.f, 0.f, 0.f, 0.f};
    bf16x8 At[4][2], B0[2][2], B1[2][2];
    const char* cA = (const char*)g.A + (size_t)cur.pm * tstep; const char* cB = (const char*)g.Bt + (size_t)cur.pn * tstep;
    S.a_ready(cur);
    if constexpr (SP2) {
        PG8_STAGE(PG8_SB(0, 0), cB, voffB); PG8_STAGE(PG8_SB(0, 1), cB + hstep, voffB); PG8_STAGE(PG8_SA(0, 0), cA, voffA); PG8_STAGE(PG8_SA(0, 1), cA + hstep, voffA);
        if (wr == 1) PG8_BAR;
        PG8_WAIT_V(2); PG8_BAR;
        PG8_STAGE(PG8_SB(1, 0), cB + kstep, voffB); PG8_STAGE(PG8_SA(1, 0), cA + kstep, voffA); PG8_STAGE(PG8_SB(1, 1), cB + hstep + kstep, voffB);
        PG8_WAIT_V(6); PG8_BAR;
    } else {
        PG8_STAGE(PG8_SB(0, 0), cB, voffB); PG8_STAGE(PG8_SA(0, 0), cA, voffA); PG8_STAGE(PG8_SB(0, 1), cB + hstep, voffB); PG8_STAGE(PG8_SA(0, 1), cA + hstep, voffA);
        if (wr == 1) PG8_BAR;
        PG8_WAIT_V(4); PG8_BAR;
        PG8_STAGE(PG8_SB(1, 0), cB + kstep, voffB); PG8_STAGE(PG8_SA(1, 0), cA + kstep, voffA); PG8_STAGE(PG8_SB(1, 1), cB + hstep + kstep, voffB);
        PG8_WAIT_V(6); PG8_BAR;
    }
    for (;;) {
        const bool has_next = S.next(ui + 1, nxt);
        const char* nA = has_next ? (const char*)g.A + (size_t)nxt.pm * tstep : cA; const char* nB = has_next ? (const char*)g.Bt + (size_t)nxt.pn * tstep : cB;
        for (int t = 0; t < nt; t += 2) {
            const bool last = (t == nt - 2);
            const char* a1 = cA + (size_t)(t + 1) * kstep;
            const char* a2 = last ? nA : cA + (size_t)(t + 2) * kstep; const char* b2 = last ? nB : cB + (size_t)(t + 2) * kstep;
            const char* a3 = a2 + kstep; const char* b3 = b2 + kstep;
            if (last && has_next) S.a_ready(nxt);
            if constexpr (SP2) {
            PG8_LDB(B0, 0, 0); PG8_LDB(B1, 0, 1); PG8_SCHED; PG8_LDA(At, 0, 0); PG8_STAGE(PG8_SA(1, 1), a1 + hstep, voffA);
            PG8_WAIT_V(8); PG8_WAIT_L(0); PG8_BAR; PG8_MMA(0, 0, At, B0); PG8_MMA(0, 1, At, B1); PG8_BAR; PG8_SCHED;
            PG8_LDA(At, 0, 1); PG8_STAGE(PG8_SB(0, 0), b2, voffB); PG8_STAGE(PG8_SB(0, 1), b2 + hstep, voffB); PG8_STAGE(PG8_SA(0, 0), a2, voffA);
            PG8_WAIT_V(8); PG8_WAIT_L(0); PG8_BAR; PG8_MMA(1, 0, At, B0); PG8_MMA(1, 1, At, B1); PG8_BAR; PG8_SCHED;
            PG8_LDB(B0, 1, 0); PG8_LDB(B1, 1, 1); PG8_SCHED; PG8_LDA(At, 1, 0); PG8_STAGE(PG8_SA(0, 1), a2 + hstep, voffA);
            PG8_WAIT_V(8); PG8_WAIT_L(0); PG8_BAR; PG8_MMA(0, 0, At, B0); PG8_MMA(0, 1, At, B1); PG8_BAR; PG8_SCHED;
            PG8_LDA(At, 1, 1); PG8_STAGE(PG8_SB(1, 0), b3, voffB); PG8_STAGE(PG8_SB(1, 1), b3 + hstep, voffB); PG8_STAGE(PG8_SA(1, 0), a3, voffA);
            PG8_WAIT_V(8); PG8_WAIT_L(0); PG8_BAR; PG8_MMA(1, 0, At, B0); PG8_MMA(1, 1, At, B1); PG8_BAR; PG8_SCHED;
            } else {
            PG8_LDB(B0, 0, 0); PG8_SCHED; PG8_LDA(At, 0, 0); PG8_STAGE(PG8_SA(1, 1), a1 + hstep, voffA);
            PG8_WAIT_L(8); PG8_BAR; PG8_WAIT_L(0); PG8_MMA(0, 0, At, B0); PG8_BAR; PG8_SCHED;
            PG8_LDB(B1, 0, 1); PG8_STAGE(PG8_SB(0, 0), b2, voffB);
            PG8_BAR; PG8_WAIT_L(0); PG8_MMA(0, 1, At, B1); PG8_BAR;
            PG8_LDA(At, 0, 1); PG8_STAGE(PG8_SA(0, 0), a2, voffA);
            PG8_BAR; PG8_WAIT_L(0); PG8_MMA(1, 0, At, B0); PG8_BAR; PG8_SCHED;
            PG8_STAGE(PG8_SB(0, 1), b2 + hstep, voffB);
            PG8_WAIT_V(6); PG8_BAR; PG8_MMA(1, 1, At, B1); PG8_BAR;
            PG8_LDB(B0, 1, 0); PG8_SCHED; PG8_LDA(At, 1, 0); PG8_STAGE(PG8_SA(0, 1), a2 + hstep, voffA);
            PG8_WAIT_L(8); PG8_BAR; PG8_WAIT_L(0); PG8_MMA(0, 0, At, B0); PG8_BAR; PG8_SCHED;
            PG8_LDB(B1, 1, 1); PG8_STAGE(PG8_SB(1, 0), b3, voffB);
            PG8_BAR; PG8_WAIT_L(0); PG8_MMA(0, 1, At, B1); PG8_BAR;
            PG8_LDA(At, 1, 1); PG8_STAGE(PG8_SA(1, 0), a3, voffA);
            PG8_BAR; PG8_WAIT_L(0); PG8_MMA(1, 0, At, B0); PG8_BAR; PG8_SCHED;
            PG8_STAGE(PG8_SB(1, 1), b3 + hstep, voffB);
            PG8_WAIT_V(6); PG8_BAR; PG8_MMA(1, 1, At, B1); PG8_BAR;
            }
        }
        if constexpr (ALIGN_EPI) { if (wr == 0) PG8_BAR; }
        if constexpr (!Epi::AFTER_DRAIN) { E(acc, cur, wr, wc, fr, fq); S.done(cur); }
        if (!has_next) break;
#pragma unroll
        for (int a = 0; a < 2; ++a)
#pragma unroll
            for (int b = 0; b < 2; ++b)
#pragma unroll
                for (int m = 0; m < 4; ++m)
#pragma unroll
                    for (int n = 0; n < 2; ++n) acc[a][b][m][n] = (f32x4){0.f, 0.f, 0.f, 0.f};
        cur = nxt; cA = nA; cB = nB; ++ui;
        if constexpr (ALIGN_EPI) { if (wr == 1) PG8_BAR; }
    }
    PG8_WAIT_V(0);
    if constexpr (!ALIGN_EPI) { if (wr == 0) PG8_BAR; }
    PG8_BAR;
    if constexpr (Epi::AFTER_DRAIN) { E.fused(acc, cur, wr, wc, fr, fq, lds, wid, lane); S.done(cur); }
#undef PG8_SA
#undef PG8_SB
#undef PG8_STAGE
#undef PG8_LDA
#undef PG8_LDB
#undef PG8_MMA
#undef PG8_WAIT_V
#undef PG8_WAIT_L
#undef PG8_BAR
#undef PG8_SCHED
}
}
namespace pg8 {
struct EpiF32 {
    static constexpr bool PERM = false, AFTER_DRAIN = false;
    float* C; int ldc;
    __device__ __forceinline__ void operator()(const f32x4 (&acc)[2][2][4][2], const Unit& u, int wr, int wc, int fr, int fq) const {
        const int row0 = u.pm * BM + wr * 64 + fr, col0 = u.pn * BM + wc * 32 + 4 * fq;
#pragma unroll
        for (int ai = 0; ai < 2; ++ai)
#pragma unroll
            for (int m = 0; m < 4; ++m) { float* rowp = C + (size_t)(row0 + ai * HALF + m * 16) * ldc + col0;
#pragma unroll
                for (int bj = 0; bj < 2; ++bj)
#pragma unroll
                    for (int n = 0; n < 2; ++n) *(f32x4*)(rowp + bj * HALF + n * 16) = acc[ai][bj][m][n]; }
    }
};
struct EpiB16 {
    static constexpr bool PERM = true, AFTER_DRAIN = false;
    bf16_t* O; int ldc;
    __device__ __forceinline__ void operator()(const f32x4 (&acc)[2][2][4][2], const Unit& u, int wr, int wc, int fr, int fq) const {
        const int row0 = u.pm * BM + wr * 64 + fr, col0 = u.pn * BM + wc * 32 + 8 * fq;
#pragma unroll
        for (int ai = 0; ai < 2; ++ai)
#pragma unroll
            for (int m = 0; m < 4; ++m) { bf16_t* rowp = O + (size_t)(row0 + ai * HALF + m * 16) * ldc + col0;
#pragma unroll
                for (int bj = 0; bj < 2; ++bj) { const f32x4 v0 = acc[ai][bj][m][0], v1 = acc[ai][bj][m][1];
                    u32x4 w; w.x = cvt_pk_bf16(v0[0], v0[1]); w.y = cvt_pk_bf16(v0[2], v0[3]); w.z = cvt_pk_bf16(v1[0], v1[1]); w.w = cvt_pk_bf16(v1[2], v1[3]);
                    *(u32x4*)(rowp + bj * HALF) = w; } }
    }
};
__device__ __forceinline__ float silu_f(float g) { return g * __builtin_amdgcn_rcpf(1.0f + __builtin_amdgcn_exp2f(-1.4426950408889634f * g)); }
struct EpiSwiGLU {
    static constexpr bool PERM = true, AFTER_DRAIN = false;
    bf16_t* H; int ldh;
    __device__ __forceinline__ void operator()(const f32x4 (&acc)[2][2][4][2], const Unit& u, int wr, int wc, int fr, int fq) const {
        const int row0 = u.pm * BM + wr * 64 + fr, col0 = u.pn * HALF + wc * 32 + 8 * fq;
#pragma unroll
        for (int ai = 0; ai < 2; ++ai)
#pragma unroll
            for (int m = 0; m < 4; ++m) { bf16_t* rowp = H + (size_t)(row0 + ai * HALF + m * 16) * ldh + col0;
                const f32x4 g0 = acc[ai][0][m][0], g1 = acc[ai][0][m][1], u0 = acc[ai][1][m][0], u1 = acc[ai][1][m][1];
                u32x4 w; w.x = cvt_pk_bf16(silu_f(g0[0]) * u0[0], silu_f(g0[1]) * u0[1]); w.y = cvt_pk_bf16(silu_f(g0[2]) * u0[2], silu_f(g0[3]) * u0[3]);
                w.z = cvt_pk_bf16(silu_f(g1[0]) * u1[0], silu_f(g1[1]) * u1[1]); w.w = cvt_pk_bf16(silu_f(g1[2]) * u1[2], silu_f(g1[3]) * u1[3]);
                *(u32x4*)rowp = w; }
    }
};
}

constexpr int NWAVES = 8, NTHREADS = 512;
constexpr int BATCH = 8, SEQ = 2048, DM = 1024, MTOK = BATCH * SEQ, DFF = 2816;
constexpr int AW = 512, AH = 8, AHD = 64, WLORA = 64, ALORA = 64, GLORA = 128, APROJ = 3 * AW + WLORA + ALORA + GLORA  ;
constexpr int BW = 512, BBLK = 8, BBD = 64, INPROJ = APROJ + 2 * BW  ;
constexpr int CH = 16, CHD = 64;
constexpr float NORM_EPS = 1e-6f, GN_EPS = 64e-5f;
constexpr int TCH = 128, NCHUNK = SEQ / TCH;

constexpr size_t MiB = 1u << 20;
constexpr size_t WS_CTL = 0;
constexpr int W_L0F1_1 = 2, W_L0F1_2 = 13, W_L0_IN = 19, W_L0_OUT = 25, W_L0F2_1 = 27, W_L0F2_2 = 38, W_L1F1_1 = 44, W_L1F1_2 = 55, W_L1_QKV = 61, W_L1_OUT = 67, W_L1F2_1 = 69, W_L1F2_2 = 80;
constexpr int R_BIG = 86, R_XN = 182, R_FREE = 214, R_END = 256;
constexpr int F_SCANIN = 0  , F_LRUIN = 12  , F_YRAW = 16  , F_LRUH = 18  , F_G = 20  , F_BONUS = 22  , F_STATE = 23  , F_LSTATE = 24;
constexpr size_t CTL_ZERO_BYTES = 1 * MiB;

typedef unsigned short bf16;
typedef float f32x4 __attribute__((ext_vector_type(4)));
typedef unsigned u32x4v __attribute__((ext_vector_type(4)));
typedef unsigned u32x2v __attribute__((ext_vector_type(2)));
#define LAS __attribute__((address_space(3)))

__device__ __forceinline__ unsigned f2bf(float f) { unsigned u = __builtin_bit_cast(unsigned, f); return (u + 0x7fffu + ((u >> 16) & 1u)) >> 16; }
__device__ __forceinline__ unsigned pk2(float lo, float hi) { return f2bf(lo) | (f2bf(hi) << 16); }
__device__ __forceinline__ float bf2f(unsigned b) { return __builtin_bit_cast(float, b << 16); }
__device__ __forceinline__ float wave_sum(float v) {
#pragma unroll
    for (int o = 1; o < 64; o <<= 1) v += __shfl_xor(v, o);
    return v;
}
__device__ __forceinline__ float softplus_f(float x) { return fmaxf(x, 0.f) + log1pf(expf(-fabsf(x))); }
__device__ __forceinline__ float sigmoid_f(float x) { return 1.0f / (1.0f + expf(-x)); }
__device__ __forceinline__ float gelu_tanh_f(float x) { const float u = 0.7978845608028654f * (x + 0.044715f * x * x * x); return 0.5f * x * (1.0f + tanhf(u)); }

enum OpKind { OP_CONV = 0, OP_ROWS = 1, OP_GEMM = 2, OP_PREP = 3, OP_SCAN = 4, OP_POST = 5, OP_ATTN = 6 };
enum { RM_COPY = 1, RM_RES = 2, RM_NORM = 4 };
enum { EPI_F32 = 0, EPI_B16 = 1, EPI_SWIGLU = 2 };
struct Op { int kind; int a, b, c, d, e, f, g; };
constexpr int MAX_OPS = 96;
struct Args { const float* in[43]; float* out; unsigned char* ws; int op_lo, op_hi; Op ops[MAX_OPS]; };

constexpr int LDSCTL_OFF = 131072, MISC_OFF = LDSCTL_OFF + 320, INTAB_OFF = LDSCTL_OFF + 512;
struct InTab { LAS const unsigned long long* t; __device__ __forceinline__ const float* operator[](int k) const { return (const float*)t[k]; } };
struct Ctx {
    LAS unsigned char* lds;
    InTab in; float* xres; unsigned char* ws;
    int tid, lane, wave, G, bid;
};

__device__ __forceinline__ void conv_item(const float* W, int K, int N, bf16* WT, int mode, LAS float* scr, int item, int lane) {
    const int nblk = N / 32, kb = item / nblk, nb = item % nblk, k0 = 64 * kb, n0 = 32 * nb;
#pragma unroll 8
    for (int i = 0; i < 32; ++i) { const int kk = 2 * i + (lane >> 5); scr[kk * 33 + (lane & 31)] = W[(size_t)(k0 + kk) * N + n0 + (lane & 31)]; }
    asm volatile("s_waitcnt lgkmcnt(0)" ::: "memory");
    int r0 = n0;
    if (mode == 1) { const int up = n0 >= DFF ? 1 : 0, j = n0 - up * DFF; r0 = (j >> 7) * 256 + up * 128 + (j & 127); }
    const int c = lane & 7;
#pragma unroll
    for (int j = 0; j < 4; ++j) { const int n = (lane >> 3) + 8 * j; const LAS float* s = scr + (8 * c) * 33 + n;
        u32x4v o; o.x = pk2(s[0 * 33], s[1 * 33]); o.y = pk2(s[2 * 33], s[3 * 33]); o.z = pk2(s[4 * 33], s[5 * 33]); o.w = pk2(s[6 * 33], s[7 * 33]);
        *(u32x4v*)(WT + (size_t)(r0 + n) * K + k0 + 8 * c) = o; }
    asm volatile("s_waitcnt lgkmcnt(0)" ::: "memory");
}
struct ConvDesc { int in_idx, K, N, dst, mode; };
__constant__ ConvDesc CONV_TAB[12] = { {3, DM, 2 * DFF, W_L0F1_1, 1}, {4, DFF, DM, W_L0F1_2, 0}, {7, DM, INPROJ, W_L0_IN, 0}, {26, DM, DM, W_L0_OUT, 0},
                             {29, DM, 2 * DFF, W_L0F2_1, 1}, {30, DFF, DM, W_L0F2_2, 0}, {33, DM, 2 * DFF, W_L1F1_1, 1}, {34, DFF, DM, W_L1F1_2, 0},
                             {37, DM, 3 * DM, W_L1_QKV, 0}, {38, DM, DM, W_L1_OUT, 0}, {41, DM, 2 * DFF, W_L1F2_1, 1}, {42, DFF, DM, W_L1F2_2, 0} };
__device__ __forceinline__ void op_conv(const Ctx& C) {
    const ConvDesc* D = CONV_TAB;
    LAS float* scr = (LAS float*)(C.lds + C.wave * 16384);
    const int gw = C.bid * NWAVES + C.wave, NGW = C.G * NWAVES;
    int base = 0;
#pragma unroll 1
    for (int d = 0; d < 12; ++d) {
        const int K = D[d].K, N = D[d].N, nit = (K / 64) * (N / 32);
        const float* W = C.in[D[d].in_idx]; bf16* WT = (bf16*)(C.ws + (size_t)D[d].dst * MiB);
        int it = ((gw - base) % NGW + NGW) % NGW;
#pragma unroll 1
        for (; it < nit; it += NGW) conv_item(W, K, N, WT, D[d].mode, scr, it, C.lane);
        base += nit;
    }
}

__device__ __forceinline__ void op_rows(const Ctx& C, const Op& op) {
    const int mode = op.a; const float coef = 0.5f * (float)op.c;
    const float* Y = (const float*)(C.ws + (size_t)op.b * MiB);
    const float* gpost = C.in[op.d]; const float* gpre = C.in[op.e];
    bf16* XN = (bf16*)(C.ws + (size_t)R_XN * MiB);
    const float* xsrc = (mode & RM_COPY) ? C.in[0] : C.xres;
    const int gw = C.bid * NWAVES + C.wave, NGW = C.G * NWAVES;
#pragma unroll 1
    for (int m = gw; m < MTOK; m += NGW) {
        const f32x4* xr = (const f32x4*)(xsrc + (size_t)m * DM) + C.lane;
        f32x4 v[4];
#pragma unroll
        for (int j = 0; j < 4; ++j) v[j] = xr[64 * j];
        if (mode & RM_RES) {
            const f32x4* yr = (const f32x4*)(Y + (size_t)m * DM) + C.lane; f32x4 y[4]; float s = 0.f;
#pragma unroll
            for (int j = 0; j < 4; ++j) { y[j] = yr[64 * j]; s += (y[j].x * y[j].x + y[j].y * y[j].y) + (y[j].z * y[j].z + y[j].w * y[j].w); }
            const float rstd = coef / sqrtf(wave_sum(s) * (1.f / DM) + NORM_EPS);
#pragma unroll
            for (int j = 0; j < 4; ++j) { const f32x4 g = ((const f32x4*)gpost)[C.lane + 64 * j]; v[j] = v[j] + y[j] * g * rstd; }
        }
        if (mode & (RM_RES | RM_COPY)) { f32x4* xo = (f32x4*)(C.xres + (size_t)m * DM) + C.lane;
#pragma unroll
            for (int j = 0; j < 4; ++j) xo[64 * j] = v[j]; }
        if (mode & RM_NORM) {
            float s = 0.f;
#pragma unroll
            for (int j = 0; j < 4; ++j) s += (v[j].x * v[j].x + v[j].y * v[j].y) + (v[j].z * v[j].z + v[j].w * v[j].w);
            const float rstd = 1.0f / sqrtf(wave_sum(s) * (1.f / DM) + NORM_EPS);
            u32x2v* o8 = (u32x2v*)(XN + (size_t)m * DM) + C.lane;
#pragma unroll
            for (int j = 0; j < 4; ++j) { const f32x4 g = ((const f32x4*)gpre)[C.lane + 64 * j]; const f32x4 o = v[j] * g * rstd; u32x2v w; w.x = pk2(o.x, o.y); w.y = pk2(o.z, o.w); o8[64 * j] = w; }
        }
    }
}

__device__ __forceinline__ void op_gemm(const Ctx& C, const Op& op) {
    pg8::Gemm g{(const pg8::bf16_t*)(C.ws + (size_t)op.a * MiB), (const pg8::bf16_t*)(C.ws + (size_t)op.b * MiB), MTOK, op.c, op.d};
    pg8::StaticOrder S; S.init(MTOK, op.c, C.G, C.bid);
    void* dst = (void*)(C.ws + (size_t)op.f * MiB);
    if (op.e == EPI_F32) { pg8::EpiF32 E{(float*)dst, op.g}; pg8::gemm_phase<pg8::EpiF32, pg8::StaticOrder, true, true>(C.lds, g, S, E); }
    else if (op.e == EPI_B16) { pg8::EpiB16 E{(pg8::bf16_t*)dst, op.g}; pg8::gemm_phase<pg8::EpiB16, pg8::StaticOrder, true, true>(C.lds, g, S, E); }
    else { pg8::EpiSwiGLU E{(pg8::bf16_t*)dst, op.g}; pg8::gemm_phase<pg8::EpiSwiGLU, pg8::StaticOrder, true, true>(C.lds, g, S, E); }
}

__device__ __forceinline__ void op_prep(const Ctx& C, const Op& op) {
    const int chunk = op.a, j = C.tid;
    const bf16* proj = (const bf16*)(C.ws + (size_t)R_BIG * MiB);
    unsigned char* fr = C.ws + (size_t)R_FREE * MiB;
    float* scanin = (float*)(fr + (size_t)F_SCANIN * MiB); float* lruin = (float*)(fr + (size_t)F_LRUIN * MiB);
    float* gbuf = (float*)(fr + (size_t)F_G * MiB); float* bonus = (float*)(fr + (size_t)F_BONUS * MiB);
    const float* mu = C.in[8]; const float* w0 = C.in[9]; const float* w2 = C.in[10]; const float* a0 = C.in[11]; const float* a2 = C.in[12]; const float* g2 = C.in[13];
    const float* k_k = C.in[14]; const float* k_a = C.in[15]; const float* r_k = C.in[16];
    const float* conv_w = C.in[19]; const float* conv_b = C.in[20]; const float* gaw = C.in[21]; const float* gab = C.in[22]; const float* gxw = C.in[23]; const float* gxb = C.in[24]; const float* lam = C.in[25];
    LAS float* rows = (LAS float*)C.lds;
    LAS float* lin = rows + 7 * INPROJ;
    LAS float* xcs = lin + 4 * 256;
#pragma unroll 1
    for (int grp = C.bid; grp < (BATCH * TCH) / 4; grp += C.G) {
        const int i0 = grp * 4, b = i0 / TCH, tt0 = i0 % TCH, t0 = chunk * TCH + tt0;
        __syncthreads();
        for (int e = C.tid; e < 7 * INPROJ; e += NTHREADS) { const int rr = e / INPROJ, col = e % INPROJ, t = t0 - 3 + rr;
            rows[e] = (t >= 0) ? bf2f(proj[((size_t)(b * SEQ + t)) * INPROJ + col]) : 0.f; }
        __syncthreads();
        for (int e = C.tid; e < 4 * 256; e += NTHREADS) { const int tk = e >> 8, i = e & 255, col = 3 * AW + i;
            const float cur = rows[(3 + tk) * INPROJ + col], prv = rows[(2 + tk) * INPROJ + col]; const float s = cur + mu[col] * (prv - cur);
            lin[e] = (i < 64) ? tanhf(s) : (i < 128 ? s : sigmoid_f(s)); }
#pragma unroll
        for (int tk = 0; tk < 4; ++tk) { float a = conv_b[j];
#pragma unroll
            for (int i = 0; i < 4; ++i) a += rows[(tk + i) * INPROJ + APROJ + j] * conv_w[i * BW + j];
            xcs[tk * 512 + j] = a; }
        __syncthreads();
        float wp[4], ap[4], gg[4], ra[4], ix[4];
#pragma unroll
        for (int tk = 0; tk < 4; ++tk) { wp[tk] = w0[j]; ap[tk] = a0[j]; gg[tk] = 0.f; ra[tk] = gab[j]; ix[tk] = gxb[j]; }
#pragma unroll 4
        for (int i = 0; i < 64; ++i) { const float ww = w2[i * AW + j], aa = a2[i * AW + j];
#pragma unroll
            for (int tk = 0; tk < 4; ++tk) { wp[tk] += lin[tk * 256 + i] * ww; ap[tk] += lin[tk * 256 + 64 + i] * aa; } }
#pragma unroll 4
        for (int i = 0; i < 128; ++i) { const float gw_ = g2[i * AW + j];
#pragma unroll
            for (int tk = 0; tk < 4; ++tk) gg[tk] += lin[tk * 256 + 128 + i] * gw_; }
        { const int n = j >> 6, jj = j & 63;
#pragma unroll 4
          for (int i = 0; i < 64; ++i) { const float wa = gaw[(n * 64 + i) * 64 + jj], wx = gxw[(n * 64 + i) * 64 + jj];
#pragma unroll
            for (int tk = 0; tk < 4; ++tk) { const float xv = xcs[tk * 512 + n * 64 + i]; ra[tk] += xv * wa; ix[tk] += xv * wx; } } }
        const int h = j >> 6, jj = j & 63;
#pragma unroll
        for (int tk = 0; tk < 4; ++tk) {
            const int tt = tt0 + tk;
            const LAS float* cur = rows + (3 + tk) * INPROJ; const LAS float* prv = rows + (2 + tk) * INPROJ;
            const float r = cur[j] + mu[j] * (prv[j] - cur[j]);
            const float k = cur[AW + j] + mu[AW + j] * (prv[AW + j] - cur[AW + j]);
            const float v = cur[2 * AW + j] + mu[2 * AW + j] * (prv[2 * AW + j] - cur[2 * AW + j]);
            const float wlog = -softplus_f(-wp[tk]) - 0.5f; const float decay = expf(-expf(wlog));
            const float a = sigmoid_f(ap[tk]);
            const float kkr = k * k_k[j]; const float ss = wave_sum(kkr * kkr); const float kk = kkr / fmaxf(sqrtf(ss), 1e-12f);
            const float kh = k * (1.0f + (a - 1.0f) * k_a[j]);
            const float bo = wave_sum(r * kh * r_k[j]);
            float* si = scanin + ((size_t)((b * AH + h) * TCH + tt)) * 384;
            si[0 * 64 + jj] = kk; si[1 * 64 + jj] = decay; si[2 * 64 + jj] = kk * a; si[3 * 64 + jj] = kh; si[4 * 64 + jj] = r; si[5 * 64 + jj] = v;
            gbuf[((size_t)(b * TCH + tt)) * AW + j] = gg[tk];
            if (jj == 0) bonus[(b * TCH + tt) * AH + h] = bo;
            const float rg = sigmoid_f(ra[tk]), ig = sigmoid_f(ix[tk]);
            const float log_a = -8.0f * rg * softplus_f(-lam[j]);
            const float al = expf(log_a), mult = sqrtf(-expm1f(2.0f * log_a));
            float* li = lruin + ((size_t)(b * TCH + tt)) * 1024;
            li[j] = al; li[512 + j] = mult * ig * xcs[tk * 512 + j];
        }
    }
}

__device__ __forceinline__ void op_scan(const Ctx& C, const Op& op) {
    const int chunk = op.a;
    unsigned char* fr = C.ws + (size_t)R_FREE * MiB;
    const float* scanin = (const float*)(fr + (size_t)F_SCANIN * MiB); const float* lruin = (const float*)(fr + (size_t)F_LRUIN * MiB);
    float* yraw = (float*)(fr + (size_t)F_YRAW * MiB); float* lruh = (float*)(fr + (size_t)F_LRUH * MiB);
    float* state = (float*)(fr + (size_t)F_STATE * MiB); float* lstate = (float*)(fr + (size_t)F_LSTATE * MiB);
#pragma unroll 1
    for (int item = C.bid; item < BATCH * AH * 4; item += C.G) {
        const int bh = item >> 2, vg = item & 3, b = bh >> 3, h = bh & 7;
        if (C.wave < 4) {
            const int row = vg * 16 + C.wave * 4 + (C.lane >> 4), k0 = 4 * (C.lane & 15);
            f32x4 S = (f32x4){0.f, 0.f, 0.f, 0.f};
            float* sp = state + ((size_t)(bh * 64 + row)) * 64 + k0;
            if (chunk > 0) S = *(const f32x4*)sp;
            const float* si = scanin + (size_t)bh * TCH * 384;
#pragma unroll 1
            for (int tt = 0; tt < TCH; ++tt) {
                const float* p = si + tt * 384;
                const f32x4 kk = *(const f32x4*)(p + k0), w = *(const f32x4*)(p + 64 + k0), kka = *(const f32x4*)(p + 128 + k0), kh = *(const f32x4*)(p + 192 + k0), r = *(const f32x4*)(p + 256 + k0);
                const float v = p[320 + row];
                float sa = (S.x * kk.x + S.y * kk.y) + (S.z * kk.z + S.w * kk.w);
                sa += __shfl_xor(sa, 1); sa += __shfl_xor(sa, 2); sa += __shfl_xor(sa, 4); sa += __shfl_xor(sa, 8);
                sa = -sa;
                S = S * w + kka * sa + kh * v;
                float y = (S.x * r.x + S.y * r.y) + (S.z * r.z + S.w * r.w);
                y += __shfl_xor(y, 1); y += __shfl_xor(y, 2); y += __shfl_xor(y, 4); y += __shfl_xor(y, 8);
                if ((C.lane & 15) == 0) yraw[((size_t)(b * TCH + tt)) * AW + h * 64 + row] = y;
            }
            *(f32x4*)sp = S;
        } else if (C.wave == 4 && vg == 0) {
            const int c = h * 64 + C.lane;
            float hs = (chunk > 0) ? lstate[b * BW + c] : 0.f;
            const float* li = lruin + (size_t)b * TCH * 1024;
#pragma unroll 4
            for (int tt = 0; tt < TCH; ++tt) { const float a = li[tt * 1024 + c], u = li[tt * 1024 + 512 + c]; hs = a * hs + u; lruh[((size_t)(b * TCH + tt)) * BW + c] = hs; }
            lstate[b * BW + c] = hs;
        }
    }
}

__device__ __forceinline__ void op_post(const Ctx& C, const Op& op) {
    const int chunk = op.a, j = C.tid, h = j >> 6, jj = j & 63;
    const bf16* proj = (const bf16*)(C.ws + (size_t)R_BIG * MiB);
    unsigned char* fr = C.ws + (size_t)R_FREE * MiB;
    const float* scanin = (const float*)(fr + (size_t)F_SCANIN * MiB);
    const float* yraw = (const float*)(fr + (size_t)F_YRAW * MiB); const float* lruh = (const float*)(fr + (size_t)F_LRUH * MiB);
    const float* gbuf = (const float*)(fr + (size_t)F_G * MiB); const float* bonus = (const float*)(fr + (size_t)F_BONUS * MiB);
    const float* lnx_g = C.in[17]; const float* lnx_b = C.in[18];
    bf16* AO = (bf16*)(C.ws + (size_t)R_XN * MiB);
#pragma unroll 1
    for (int i = C.bid; i < BATCH * TCH; i += C.G) {
        const int b = i / TCH, tt = i % TCH, t = chunk * TCH + tt; const size_t m = (size_t)b * SEQ + t;
        const float y = yraw[(size_t)i * AW + j];
        const float mean = wave_sum(y) * (1.f / 64.f); const float d = y - mean; const float var = wave_sum(d * d) * (1.f / 64.f);
        const float yn = d * (1.0f / sqrtf(var + GN_EPS)) * lnx_g[j] + lnx_b[j];
        const float v = scanin[((size_t)((b * AH + h) * TCH + tt)) * 384 + 320 + jj];
        const float ya = (yn + bonus[i * AH + h] * v) * gbuf[(size_t)i * AW + j];
        const float gb = bf2f(proj[m * INPROJ + APROJ + BW + j]);
        const float yb = lruh[(size_t)i * BW + j] * gelu_tanh_f(gb);
        AO[m * DM + j] = (bf16)f2bf(ya); AO[m * DM + AW + j] = (bf16)f2bf(yb);
    }
}

__device__ __forceinline__ void op_attn(const Ctx& C, const Op& op) {
    const bf16* QKV = (const bf16*)(C.ws + (size_t)R_BIG * MiB);
    bf16* O = (bf16*)(C.ws + (size_t)R_XN * MiB);
    LAS float* Ks = (LAS float*)C.lds;
    LAS float* Vs = Ks + 64 * 64;
#pragma unroll 1
    for (int item = C.bid; item < BATCH * CH * 4; item += C.G) {
        const int qb = 3 - (item & 3), bh = item >> 2, b = bh >> 4, h = bh & 15;
        const int q = qb * 512 + C.wave * 64 + C.lane; const size_t mq = (size_t)b * SEQ + q;
        float qv[64], o[64];
#pragma unroll
        for (int d8 = 0; d8 < 8; ++d8) { const u32x4v w = *(const u32x4v*)(QKV + mq * 3072 + h * 64 + d8 * 8);
            qv[d8 * 8 + 0] = bf2f(w.x & 0xffffu) * 0.125f; qv[d8 * 8 + 1] = bf2f(w.x >> 16) * 0.125f; qv[d8 * 8 + 2] = bf2f(w.y & 0xffffu) * 0.125f; qv[d8 * 8 + 3] = bf2f(w.y >> 16) * 0.125f;
            qv[d8 * 8 + 4] = bf2f(w.z & 0xffffu) * 0.125f; qv[d8 * 8 + 5] = bf2f(w.z >> 16) * 0.125f; qv[d8 * 8 + 6] = bf2f(w.w & 0xffffu) * 0.125f; qv[d8 * 8 + 7] = bf2f(w.w >> 16) * 0.125f; }
#pragma unroll
        for (int d = 0; d < 64; ++d) o[d] = 0.f;
        float carry = 0.f;
        const int ntile = (qb * 512 + 512) / 64;
#pragma unroll 1
        for (int kt = ntile - 1; kt >= 0; --kt) {
            __syncthreads();
            {
                const int key = C.tid >> 3, d8 = C.tid & 7; const size_t mk = (size_t)b * SEQ + kt * 64 + key;
                const u32x4v kw = *(const u32x4v*)(QKV + mk * 3072 + 1024 + h * 64 + d8 * 8), vw = *(const u32x4v*)(QKV + mk * 3072 + 2048 + h * 64 + d8 * 8);
                LAS float* kd = Ks + key * 64 + d8 * 8; LAS float* vd = Vs + key * 64 + d8 * 8;
                kd[0] = bf2f(kw.x & 0xffffu); kd[1] = bf2f(kw.x >> 16); kd[2] = bf2f(kw.y & 0xffffu); kd[3] = bf2f(kw.y >> 16); kd[4] = bf2f(kw.z & 0xffffu); kd[5] = bf2f(kw.z >> 16); kd[6] = bf2f(kw.w & 0xffffu); kd[7] = bf2f(kw.w >> 16);
                vd[0] = bf2f(vw.x & 0xffffu); vd[1] = bf2f(vw.x >> 16); vd[2] = bf2f(vw.y & 0xffffu); vd[3] = bf2f(vw.y >> 16); vd[4] = bf2f(vw.z & 0xffffu); vd[5] = bf2f(vw.z >> 16); vd[6] = bf2f(vw.w & 0xffffu); vd[7] = bf2f(vw.w >> 16);
            }
            __syncthreads();
            if (kt * 64 > qb * 512 + C.wave * 64 + 63) continue;
#pragma unroll 1
            for (int kk = 63; kk >= 0; --kk) {
                const int key = kt * 64 + kk;
                const LAS f32x4* kr = (const LAS f32x4*)(Ks + kk * 64);
                float z0 = 0.f, z1 = 0.f;
#pragma unroll
                for (int d4 = 0; d4 < 16; ++d4) { const f32x4 kv = kr[d4]; z0 += qv[4 * d4] * kv.x + qv[4 * d4 + 1] * kv.y; z1 += qv[4 * d4 + 2] * kv.z + qv[4 * d4 + 3] * kv.w; }
                const float z = z0 + z1;
                const bool live = key < q;
                const float sp = live ? softplus_f(z) : 0.f;
                carry += sp;
                const float att = live ? expf(z - carry) : 0.f;
                const LAS f32x4* vr = (const LAS f32x4*)(Vs + kk * 64);
#pragma unroll
                for (int d4 = 0; d4 < 16; ++d4) { const f32x4 vv = vr[d4]; o[4 * d4] += att * vv.x; o[4 * d4 + 1] += att * vv.y; o[4 * d4 + 2] += att * vv.z; o[4 * d4 + 3] += att * vv.w; }
            }
        }
        bf16* op_ = O + mq * DM + h * 64;
#pragma unroll
        for (int d8 = 0; d8 < 8; ++d8) { u32x4v w; w.x = pk2(o[d8 * 8], o[d8 * 8 + 1]); w.y = pk2(o[d8 * 8 + 2], o[d8 * 8 + 3]); w.z = pk2(o[d8 * 8 + 4], o[d8 * 8 + 5]); w.w = pk2(o[d8 * 8 + 6], o[d8 * 8 + 7]); *(u32x4v*)(op_ + d8 * 8) = w; }
    }
}

constexpr int LDS_BYTES = 147456;
#define GAS __attribute__((address_space(1)))
typedef GAS unsigned gu32;
constexpr int CW_BAR = 4096;
#define XB_TMO      128
#define XB_XCNT(j)  (256  + 64 * (j))
#define XB_XSUB(j)  (1280 + 64 * (j))
#define XB_XGEN(j)  (2304 + 64 * (j))
#define XB_TOP      3328
#define XB_TOPGEN   3392
#define XCD_BAR_WORDS 3456
#define XB_SPIN_CAP (1u << 18)

__device__ __forceinline__ unsigned xb_ld(unsigned* p)              { return __hip_atomic_load(p, __ATOMIC_RELAXED, __HIP_MEMORY_SCOPE_AGENT); }
__device__ __forceinline__ unsigned xb_add(unsigned* p, unsigned v) { return __hip_atomic_fetch_add(p, v, __ATOMIC_RELAXED, __HIP_MEMORY_SCOPE_AGENT); }
__device__ __forceinline__ unsigned xb_xcc_id() { return (unsigned)__builtin_amdgcn_s_getreg((3 << 11) | 20) & 0xFu; }
#define XB_SPIN(cond, bar) do { unsigned _sp = 0; while (cond) { __builtin_amdgcn_s_sleep(1); \
    if ((++_sp & 255u) == 0u) { if (xb_ld(&(bar)[XB_TMO])) break; if (_sp > XB_SPIN_CAP) { atomicAdd(&(bar)[XB_TMO], 1u); break; } } } } while (0)

struct XcdBarrier {
    unsigned* bar; unsigned x;
    volatile LAS unsigned* st;
};

__device__ __forceinline__ XcdBarrier xcd_barrier_post(unsigned* bar, volatile LAS unsigned* st) {
    XcdBarrier b; b.bar = bar; b.x = xb_xcc_id(); b.st = st;
    if (threadIdx.x == 0) (void)xb_add(&bar[XB_XCNT(b.x)], 1u);
    return b;
}
__device__ __forceinline__ void xcd_barrier_complete(unsigned* bar, unsigned x, unsigned& nloc, unsigned& nx) {
    const unsigned G = gridDim.x * gridDim.y * gridDim.z;
    unsigned sum, cnt, mine, sp = 0u;
    for (;;) {
        sum = 0u; cnt = 0u; mine = 0u;
#pragma unroll
        for (unsigned j = 0; j < 16; ++j) { const unsigned c = xb_ld(&bar[XB_XCNT(j)]); sum += c; cnt += (c > 0u) ? 1u : 0u; mine = (j == x) ? c : mine; }
        if (sum == G) break;
        __builtin_amdgcn_s_sleep(1);
        if ((++sp & 255u) == 0u) { if (xb_ld(&bar[XB_TMO])) break; if (sp > XB_SPIN_CAP) { atomicAdd(&bar[XB_TMO], 1u); break; } }
    }
    nloc = mine > 0u ? mine : 1u; nx = cnt > 0u ? cnt : 1u;
}

__device__ __forceinline__ void xcd_barrier(const XcdBarrier& b) {
    asm volatile("s_waitcnt vmcnt(0)" ::: "memory");
    __syncthreads();
    if (threadIdx.x == 0) {
        unsigned* bar = b.bar;
        __builtin_amdgcn_s_waitcnt(0);
        unsigned nloc = b.st[0], nx = b.st[1];
        if (nloc == 0u) { xcd_barrier_complete(bar, b.x, nloc, nx); b.st[0] = nloc; b.st[1] = nx; }
        const unsigned old = xb_add(&bar[XB_XSUB(b.x)], 1u);
        const unsigned gen = old / nloc;
        if (old + 1u == (gen + 1u) * nloc) {
            __builtin_amdgcn_fence(__ATOMIC_RELEASE, "agent");
            asm volatile("s_waitcnt vmcnt(0)" ::: "memory");
            const unsigned og = xb_add(&bar[XB_TOP], 1u);
            const unsigned tg = og / nx;
            if (og + 1u == (tg + 1u) * nx) xb_add(&bar[XB_TOPGEN], 1u);
            else XB_SPIN(xb_ld(&bar[XB_TOPGEN]) == tg, bar);
            __builtin_amdgcn_fence(__ATOMIC_ACQUIRE, "agent");
            xb_add(&bar[XB_XGEN(b.x)], 1u);
            asm volatile("s_waitcnt vmcnt(0)" ::: "memory");
        } else {
            XB_SPIN(xb_ld(&bar[XB_XGEN(b.x)]) == gen, bar);
            __builtin_amdgcn_fence(__ATOMIC_ACQUIRE, "agent");
            asm volatile("s_waitcnt vmcnt(0)" ::: "memory");
        }
    }
    __syncthreads();
}


namespace cg = cooperative_groups;
__global__ void __launch_bounds__(NTHREADS, 2) mk_fwd(Args args) {
    extern __shared__ __attribute__((aligned(16))) unsigned char lds[];
    LAS unsigned char* L = (LAS unsigned char*)lds;
    for (int u = threadIdx.x; u < (LDS_BYTES - LDSCTL_OFF) / 4; u += NTHREADS) ((LAS unsigned*)(L + LDSCTL_OFF))[u] = 0u;
    __syncthreads();
    if (threadIdx.x < 43) ((LAS unsigned long long*)(L + INTAB_OFF))[threadIdx.x] = (unsigned long long)args.in[threadIdx.x];
    __syncthreads();
    XcdBarrier bar = xcd_barrier_post((unsigned*)(args.ws + WS_CTL) + CW_BAR, (volatile LAS unsigned*)(L + MISC_OFF) + 8);
    cg::this_grid().sync();
#pragma unroll 1
    for (int oi = args.op_lo; oi < args.op_hi; ++oi) {
        const Op op = args.ops[oi];
        Ctx C;
        { int t = threadIdx.x; asm volatile("" : "+v"(t)); unsigned char* w = args.ws; asm volatile("" : "+s"(w)); float* xo = args.out; asm volatile("" : "+s"(xo));
          C.tid = t; C.lane = t & 63; C.wave = __builtin_amdgcn_readfirstlane(t >> 6); C.ws = w; C.xres = xo; C.G = gridDim.x; C.bid = blockIdx.x;
          C.lds = L; C.in.t = (LAS const unsigned long long*)(L + INTAB_OFF); }
        switch (op.kind) {
            case OP_CONV: op_conv(C); break;
            case OP_ROWS: op_rows(C, op); break;
            case OP_GEMM: op_gemm(C, op); break;
            case OP_PREP: op_prep(C, op); break;
            case OP_SCAN: op_scan(C, op); break;
            case OP_POST: op_post(C, op); break;
            case OP_ATTN: op_attn(C, op); break;
        }
        if (oi + 1 < args.op_hi) xcd_barrier(bar);
    }
}

static int build_ops(Op* ops) {
    int n = 0;
    auto add = [&](int kind, int a = 0, int b = 0, int c = 0, int d = 0, int e = 0, int f = 0, int g = 0) { ops[n++] = Op{kind, a, b, c, d, e, f, g}; };
    auto ffn = [&](int w1, int w2, int gpost, int gpre_next) {
        add(OP_GEMM, R_XN, w1, 2 * DFF, DM, EPI_SWIGLU, R_BIG, DFF);
        add(OP_GEMM, R_BIG, w2, DM, DFF, EPI_F32, R_XN, DM);
        add(OP_ROWS, RM_RES, R_XN, 1, gpost, 0);
        if (gpre_next >= 0) add(OP_ROWS, RM_NORM, 0, 0, 0, gpre_next);
    };
    add(OP_CONV);
    add(OP_ROWS, RM_COPY | RM_NORM, 0, 0, 0, 1);
    ffn(W_L0F1_1, W_L0F1_2, 2, 5);
    add(OP_GEMM, R_XN, W_L0_IN, INPROJ, DM, EPI_B16, R_BIG, INPROJ);
    for (int c = 0; c < NCHUNK; ++c) { add(OP_PREP, c); add(OP_SCAN, c); add(OP_POST, c); }
    add(OP_GEMM, R_XN, W_L0_OUT, DM, DM, EPI_F32, R_BIG, DM);
    add(OP_ROWS, RM_RES | RM_NORM, R_BIG, 2, 6, 27);
    ffn(W_L0F2_1, W_L0F2_2, 28, 31);
    ffn(W_L1F1_1, W_L1F1_2, 32, 35);
    add(OP_GEMM, R_XN, W_L1_QKV, 3 * DM, DM, EPI_B16, R_BIG, 3 * DM);
    add(OP_ATTN);
    add(OP_GEMM, R_XN, W_L1_OUT, DM, DM, EPI_F32, R_BIG, DM);
    add(OP_ROWS, RM_RES | RM_NORM, R_BIG, 2, 36, 39);
    ffn(W_L1F2_1, W_L1F2_2, 40, -1);
    return n;
}

extern "C" void kernel_launch(void* const* d_in, const int* in_sizes, int n_in, void* d_out, int out_size, void* d_ws, size_t ws_size, hipStream_t stream) {
    static int grid = 0;
    if (grid == 0) {
        if (n_in != 43 || in_sizes[0] != MTOK * DM || out_size != MTOK * DM || ws_size < (size_t)R_END * MiB) { fprintf(stderr, "kernel_launch: unexpected shapes (n_in %d, in0 %d, out %d, ws %zu)\n", n_in, n_in > 0 ? in_sizes[0] : -1, out_size, ws_size); grid = -1; return; }
        if (hipFuncSetAttribute((const void*)mk_fwd, hipFuncAttributeMaxDynamicSharedMemorySize, LDS_BYTES) != hipSuccess) { fprintf(stderr, "kernel_launch: hipFuncSetAttribute failed\n"); grid = -1; return; }
        int dev = 0, cus = 0, per_cu = 0;
        if (hipGetDevice(&dev) != hipSuccess || hipDeviceGetAttribute(&cus, hipDeviceAttributeMultiprocessorCount, dev) != hipSuccess) { grid = -1; return; }
        if (hipOccupancyMaxActiveBlocksPerMultiprocessor(&per_cu, (const void*)mk_fwd, NTHREADS, LDS_BYTES) != hipSuccess || per_cu < 1) { fprintf(stderr, "kernel_launch: occupancy query failed (%d)\n", per_cu); grid = -1; return; }
        grid = cus * per_cu;
    }
    if (grid < 0) return;
    if (hipMemsetAsync((char*)d_ws + WS_CTL, 0, CTL_ZERO_BYTES, stream) != hipSuccess) { fprintf(stderr, "kernel_launch: hipMemsetAsync failed\n"); return; }
    Args a{};
    for (int i = 0; i < 43; ++i) a.in[i] = (const float*)d_in[i];
    a.out = (float*)d_out; a.ws = (unsigned char*)d_ws;
    const int nops = build_ops(a.ops);
    a.op_lo = 0; a.op_hi = nops;
    void* kargs[] = {&a};
    const hipError_t e = hipLaunchCooperativeKernel((const void*)mk_fwd, dim3(grid), dim3(NTHREADS), kargs, LDS_BYTES, stream);
    if (e != hipSuccess) fprintf(stderr, "kernel_launch: cooperative launch failed: %s (grid %d)\n", hipGetErrorString(e), grid);
}
```

```cpp
#include <hip/hip_runtime.h>
#include <hip/hip_cooperative_groups.h>
#include <cstdio>
#include <cstdint>
namespace pg8 {
#define PG8_LAS __attribute__((address_space(3)))
typedef unsigned short bf16_t;
typedef short bf16x8 __attribute__((ext_vector_type(8)));
typedef float f32x4 __attribute__((ext_vector_type(4)));
typedef unsigned u32x4 __attribute__((ext_vector_type(4)));
constexpr int BM = 256, BK = 64, HALF = 128, HTB = HALF * BK * 2  , STAGE_BYTES = 8 * HTB, NXCD = 8, WGM = 8;

__host__ __device__ __forceinline__ int lds_byte(int r, int c) { const int st = (r >> 4) * 2 + (c >> 5), rr = r & 15, cc = c & 31, ob = rr * 64 + cc * 2; return st * 1024 + (ob ^ (((ob >> 9) & 1) << 5)); }
__host__ __device__ __forceinline__ void stage_rc(int b, int& R, int& C) { const int st = b / 1024, sb = b % 1024, swz = sb ^ (((sb >> 9) & 1) << 5); R = (st >> 1) * 16 + swz / 64; C = (st & 1) * 32 + (swz % 64) / 2; }
__host__ __device__ __forceinline__ int perm32(int rho) { const int n = rho >> 4, i = rho & 15; return 8 * (i >> 2) + 4 * n + (i & 3); }

struct Unit { int pm, pn; };
struct Gemm { const bf16_t* A; const bf16_t* Bt; int M, N, K; };

struct StaticOrder {
    int nM, nN, nwg, G, c;
    __host__ __device__ void init(int M, int N, int G_, int c_) { nM = M / BM; nN = N / BM; nwg = nM * nN; G = G_; c = c_; }
    __host__ __device__ bool next(int i, Unit& u) const {
        const long L = (long)i * G + c; if (L >= nwg) return false;
        int wgid = (int)L; { const int q = nwg / NXCD, r = nwg % NXCD, xcd = wgid % NXCD, off = wgid / NXCD; wgid = (xcd < r ? xcd * (q + 1) : r * (q + 1) + (xcd - r) * q) + off; }
        const int nig = WGM * nN, gid = wgid / nig, fm = gid * WGM, gsz = (nM - fm) < WGM ? (nM - fm) : WGM;
        u.pm = fm + ((wgid % nig) % gsz); u.pn = (wgid % nig) / gsz; return true;
    }
    __device__ __forceinline__ void a_ready(const Unit&) const {}
    __device__ __forceinline__ void done(const Unit&) const {}
};

__device__ __forceinline__ unsigned cvt_pk_bf16(float lo, float hi) { unsigned r; asm volatile("v_cvt_pk_bf16_f32 %0, %1, %2" : "=v"(r) : "v"(lo), "v"(hi)); return r; }
typedef float f32x2 __attribute__((ext_vector_type(2)));
__device__ __forceinline__ f32x2 gelu_pk(f32x2 v) {
    const f32x2 av = __builtin_elementwise_abs(v), d = av * 0.2316418882f + 1.0f;
    f32x2 t; t.x = __builtin_amdgcn_rcpf(d.x); t.y = __builtin_amdgcn_rcpf(d.y);
    f32x2 q = t * 0.5307027145f + (-0.7265760135f); q = q * t + 0.7107068705f; q = q * t + (-0.142248368f); q = q * t + 0.127414796f; q = q * t;
    const f32x2 s = (v * v) * (-0.72134752044f);
    f32x2 e; e.x = __builtin_amdgcn_exp2f(s.x); e.y = __builtin_amdgcn_exp2f(s.y);
    const f32x2 m = v * (q * e), r = v - m;
    f32x2 o; o.x = v.x < 0.f ? m.x : r.x; o.y = v.y < 0.f ? m.y : r.y; return o;
}

template <int ACT  > struct EpiBf16 {
    static constexpr bool PERM = true, AFTER_DRAIN = false; static_assert(ACT == 0 || ACT == 1, "EpiBf16: ACT is 0 (none) or 1 (gelu_pk)");
    bf16_t* O; int ldc; const float* bias; int split_cols; size_t split_stride; float scale0;
    __device__ __forceinline__ void operator()(const f32x4 (&acc)[2][2][4][2], const Unit& u, int wr, int wc, int fr, int fq) const {
        const int row0 = u.pm * BM + wr * 64 + fr; int colt = u.pn * BM; bf16_t* base = O;
        float sc = 1.f; if (split_cols) { const int t = colt / split_cols; base += (size_t)t * split_stride; colt -= t * split_cols; if (t == 0) sc = scale0; }
        const int col0 = colt + wc * 32 + 8 * fq, bcol0 = u.pn * BM + wc * 32 + 8 * fq;
        f32x4 bv[2][2];
#pragma unroll
        for (int bj = 0; bj < 2; ++bj)
#pragma unroll
            for (int n = 0; n < 2; ++n) bv[bj][n] = bias ? *(const f32x4*)(bias + bcol0 + bj * HALF + 4 * n) : (f32x4){0.f, 0.f, 0.f, 0.f};
#pragma unroll
        for (int ai = 0; ai < 2; ++ai)
#pragma unroll
            for (int m = 0; m < 4; ++m) { bf16_t* rowp = base + (size_t)(row0 + ai * HALF + m * 16) * ldc + col0;
#pragma unroll
                for (int bj = 0; bj < 2; ++bj) { f32x4 v0 = acc[ai][bj][m][0] + bv[bj][0], v1 = acc[ai][bj][m][1] + bv[bj][1];
                    if (ACT == 1) { f32x2 a = gelu_pk((f32x2){v0[0], v0[1]}), b = gelu_pk((f32x2){v0[2], v0[3]}), c = gelu_pk((f32x2){v1[0], v1[1]}), d = gelu_pk((f32x2){v1[2], v1[3]});
                        v0 = (f32x4){a.x, a.y, b.x, b.y}; v1 = (f32x4){c.x, c.y, d.x, d.y}; }
                    v0 = v0 * sc; v1 = v1 * sc; u32x4 w; w.x = cvt_pk_bf16(v0[0], v0[1]); w.y = cvt_pk_bf16(v0[2], v0[3]); w.z = cvt_pk_bf16(v1[0], v1[1]); w.w = cvt_pk_bf16(v1[2], v1[3]);
                    *(u32x4*)(rowp + bj * HALF) = w; } }
    }
};

struct PanelStats {
    unsigned* xbuf;
    unsigned* cnt;
    unsigned* tmo;
    int ntn; float eps;
    unsigned code;
    __device__ __forceinline__ bool run(const f32x4 (&v)[2][2][4][2], const Unit& u, int wr, int wc, int fr, int fq, PG8_LAS unsigned char* lds, int wid, int lane) const {
        typedef float f32x2v __attribute__((ext_vector_type(2)));
        PG8_LAS f32x2v* P = (PG8_LAS f32x2v*)lds;
        PG8_LAS f32x2v* S = (PG8_LAS f32x2v*)(lds + 8192);
        PG8_LAS unsigned* flag = (PG8_LAS unsigned*)(lds + 8192 + 2048);
#pragma unroll
        for (int ai = 0; ai < 2; ++ai)
#pragma unroll
            for (int m = 0; m < 4; ++m) {
                float s = 0.f;
#pragma unroll
                for (int bj = 0; bj < 2; ++bj)
#pragma unroll
                    for (int n = 0; n < 2; ++n) { const f32x4 x = v[ai][bj][m][n]; s += (x[0] + x[1]) + (x[2] + x[3]); }
                s += __shfl_xor(s, 16); s += __shfl_xor(s, 32);
                const float mw = s * (1.0f / 64.0f); float q = 0.f;
#pragma unroll
                for (int bj = 0; bj < 2; ++bj)
#pragma unroll
                    for (int n = 0; n < 2; ++n) { const f32x4 d = v[ai][bj][m][n] - mw; q += (d[0] * d[0] + d[1] * d[1]) + (d[2] * d[2] + d[3] * d[3]); }
                q += __shfl_xor(q, 16); q += __shfl_xor(q, 32);
                if (fq == 0) P[(ai * HALF + wr * 64 + m * 16 + fr) * 4 + wc] = (f32x2v){mw, q};
            }
        asm volatile("s_waitcnt lgkmcnt(0)" ::: "memory"); __builtin_amdgcn_s_barrier(); asm volatile("" ::: "memory");
#if defined(BROKEN_EXCHANGE_NO_WAIT)
#warning BROKEN CONTROL BUILD: the row-statistics exchange does not wait; results are wrong by design
        if (blockIdx.x >= 64) { const long long t0_ = clock64(); while (clock64() - t0_ < 60000) __builtin_amdgcn_s_sleep(8); }
#endif
        const int row = wid * 32 + (lane & 31);
        if (lane < 32) {
            const f32x2v a = P[row * 4 + 0], b = P[row * 4 + 1], c = P[row * 4 + 2], d = P[row * 4 + 3];
            const float mt = (a.x + b.x + c.x + d.x) * 0.25f;
            const float da = a.x - mt, db = b.x - mt, dc = c.x - mt, dd = d.x - mt;
            const float m2 = (a.y + b.y) + (c.y + d.y) + 64.0f * ((da * da + db * db) + (dc * dc + dd * dd));
            unsigned long long* slot = (unsigned long long*)xbuf + ((size_t)(u.pm * BM + row) * 4 + u.pn);
            __hip_atomic_store(slot, ((unsigned long long)__float_as_uint(m2) << 32) | __float_as_uint(mt), __ATOMIC_RELAXED, __HIP_MEMORY_SCOPE_AGENT);
        }
        asm volatile("s_waitcnt vmcnt(0)" ::: "memory");
        if (lane == 0) __hip_atomic_fetch_add(cnt + 64 * u.pm, 1u, __ATOMIC_RELAXED, __HIP_MEMORY_SCOPE_AGENT);
        if (wid == 0) {
            bool dead = false; const unsigned long long t0 = __builtin_amdgcn_s_memrealtime(); const unsigned want = 8u * (unsigned)ntn;
            for (;;) {
#if defined(BROKEN_EXCHANGE_NO_WAIT)
                break;
#endif
                if ((unsigned)__builtin_amdgcn_readfirstlane(__hip_atomic_load(cnt + 64 * u.pm, __ATOMIC_RELAXED, __HIP_MEMORY_SCOPE_AGENT)) >= want) break;
                if (__builtin_amdgcn_s_memrealtime() - t0 > 2000000ull) {
                    if (lane == 0) { unsigned expect = 0u; __hip_atomic_compare_exchange_strong(tmo + 1, &expect, code | (unsigned)(u.pm & 0xff), __ATOMIC_RELAXED, __ATOMIC_RELAXED, __HIP_MEMORY_SCOPE_AGENT);
                                     __hip_atomic_store(tmo, 1u, __ATOMIC_RELAXED, __HIP_MEMORY_SCOPE_AGENT); }
                    dead = true; break; }
                __builtin_amdgcn_s_sleep(2);
            }
            __builtin_amdgcn_fence(__ATOMIC_ACQUIRE, "agent");
            if (lane == 0) flag[0] = dead ? 1u : 0u;
        }
        asm volatile("s_waitcnt vmcnt(0) lgkmcnt(0)" ::: "memory"); __builtin_amdgcn_s_barrier(); asm volatile("" ::: "memory");
        const bool bad = flag[0] != 0u;
        if (lane < 32) {
            const unsigned long long* slot = (const unsigned long long*)xbuf + (size_t)(u.pm * BM + row) * 4; float mt[4], m2[4]; float ms = 0.f;
#pragma unroll
            for (int t = 0; t < 4; ++t) { if (t < ntn) { const unsigned long long w = __hip_atomic_load(slot + t, __ATOMIC_RELAXED, __HIP_MEMORY_SCOPE_AGENT); mt[t] = __uint_as_float((unsigned)w); m2[t] = __uint_as_float((unsigned)(w >> 32)); } else { mt[t] = 0.f; m2[t] = 0.f; } ms += mt[t]; }
            const float mean = ms / (float)ntn; float q = 0.f;
#pragma unroll
            for (int t = 0; t < 4; ++t) if (t < ntn) { const float dm = mt[t] - mean; q += m2[t] + 256.0f * dm * dm; }
            S[row] = (f32x2v){mean, 1.0f / sqrtf(q / (256.0f * (float)ntn) + eps)};
        }
        asm volatile("s_waitcnt lgkmcnt(0)" ::: "memory"); __builtin_amdgcn_s_barrier(); asm volatile("" ::: "memory");
        return bad;
    }
};
struct EpiLnRes {
    static constexpr bool PERM = false, AFTER_DRAIN = true;
    const float* base; float* out; int ldc; const float* bias; PanelStats st; unsigned poison;
    __device__ __forceinline__ void fused(f32x4 (&acc)[2][2][4][2], const Unit& u, int wr, int wc, int fr, int fq, PG8_LAS unsigned char* lds, int wid, int lane) const {
        typedef float f32x2v __attribute__((ext_vector_type(2)));
        const PG8_LAS f32x2v* S = (const PG8_LAS f32x2v*)(lds + 8192);
        const int col0 = u.pn * BM + wc * 32 + 4 * fq;
#pragma unroll
        for (int bj = 0; bj < 2; ++bj)
#pragma unroll
            for (int n = 0; n < 2; ++n) { const f32x4 bv = bias ? *(const f32x4*)(bias + col0 + bj * HALF + n * 16) : (f32x4){0.f, 0.f, 0.f, 0.f};
#pragma unroll
                for (int ai = 0; ai < 2; ++ai)
#pragma unroll
                    for (int m = 0; m < 4; ++m) acc[ai][bj][m][n] += bv; }
        f32x4 pre[4][2][2];
#pragma unroll
        for (int m = 0; m < 4; ++m) { const size_t off = (size_t)(u.pm * BM + wr * 64 + m * 16 + fr) * ldc + col0;
#pragma unroll
            for (int bj = 0; bj < 2; ++bj)
#pragma unroll
                for (int n = 0; n < 2; ++n) pre[m][bj][n] = *(const f32x4*)(base + off + bj * HALF + n * 16); }
        const bool bad = st.run(acc, u, wr, wc, fr, fq, lds, wid, lane) || poison != 0u;
        const float qnan = __builtin_nanf("");
#pragma unroll
        for (int ai = 0; ai < 2; ++ai)
#pragma unroll
            for (int m = 0; m < 4; ++m) { const int r = ai * HALF + wr * 64 + m * 16 + fr; const f32x2v sr = S[r]; const size_t off = (size_t)(u.pm * BM + r) * ldc + col0;
#pragma unroll
                for (int bj = 0; bj < 2; ++bj)
#pragma unroll
                    for (int n = 0; n < 2; ++n) { const f32x4 bs = ai == 0 ? pre[m][bj][n] : *(const f32x4*)(base + off + bj * HALF + n * 16); f32x4 o = bs + (acc[ai][bj][m][n] - sr.x) * sr.y;
                        if (bad) o = (f32x4){qnan, qnan, qnan, qnan}; *(f32x4*)(out + off + bj * HALF + n * 16) = o; }
                if (m & 1) asm volatile("" ::: "memory"); }
    }
};
struct EpiLnResLn {
    static constexpr bool PERM = false, AFTER_DRAIN = true;
    const float* base; float* out; bf16_t* xn; int ldc; const float* bias; PanelStats st1, st2; unsigned poison;
    __device__ __forceinline__ void fused(f32x4 (&acc)[2][2][4][2], const Unit& u, int wr, int wc, int fr, int fq, PG8_LAS unsigned char* lds, int wid, int lane) const {
        typedef float f32x2v __attribute__((ext_vector_type(2))); typedef unsigned u32x2v __attribute__((ext_vector_type(2)));
        const PG8_LAS f32x2v* S = (const PG8_LAS f32x2v*)(lds + 8192);
        const int col0 = u.pn * BM + wc * 32 + 4 * fq;
#pragma unroll
        for (int bj = 0; bj < 2; ++bj)
#pragma unroll
            for (int n = 0; n < 2; ++n) { const f32x4 bv = bias ? *(const f32x4*)(bias + col0 + bj * HALF + n * 16) : (f32x4){0.f, 0.f, 0.f, 0.f};
#pragma unroll
                for (int ai = 0; ai < 2; ++ai)
#pragma unroll
                    for (int m = 0; m < 4; ++m) acc[ai][bj][m][n] += bv; }
        bool bad = st1.run(acc, u, wr, wc, fr, fq, lds, wid, lane) || poison != 0u;
        const float qnan = __builtin_nanf("");
#pragma unroll
        for (int ai = 0; ai < 2; ++ai)
#pragma unroll
            for (int m = 0; m < 4; ++m) { const int r = ai * HALF + wr * 64 + m * 16 + fr; const f32x2v sr = S[r]; const size_t off = (size_t)(u.pm * BM + r) * ldc + col0;
#pragma unroll
                for (int bj = 0; bj < 2; ++bj)
#pragma unroll
                    for (int n = 0; n < 2; ++n) { const f32x4 bs = *(const f32x4*)(base + off + bj * HALF + n * 16); acc[ai][bj][m][n] = bs + (acc[ai][bj][m][n] - sr.x) * sr.y; }
                asm volatile("" : "+v"(acc[ai][0][m][0]), "+v"(acc[ai][0][m][1]), "+v"(acc[ai][1][m][0]), "+v"(acc[ai][1][m][1]));
                if (m & 1) asm volatile("" ::: "memory"); }
        const bool bad1 = bad;
        bad = st2.run(acc, u, wr, wc, fr, fq, lds, wid, lane) || bad;
#pragma unroll
        for (int ai = 0; ai < 2; ++ai)
#pragma unroll
            for (int m = 0; m < 4; ++m) { const int r = ai * HALF + wr * 64 + m * 16 + fr; const f32x2v sr = S[r]; const size_t off = (size_t)(u.pm * BM + r) * ldc + col0;
#pragma unroll
                for (int bj = 0; bj < 2; ++bj)
#pragma unroll
                    for (int n = 0; n < 2; ++n) { const f32x4 x1 = acc[ai][bj][m][n]; *(f32x4*)(out + off + bj * HALF + n * 16) = bad1 ? (f32x4){qnan, qnan, qnan, qnan} : x1;
                        const f32x4 o = (x1 - sr.x) * sr.y; u32x2v w; w.x = cvt_pk_bf16(o[0], o[1]); w.y = cvt_pk_bf16(o[2], o[3]);
                        if (bad) { w.x = 0x7fc07fc0u; w.y = 0x7fc07fc0u; } *(u32x2v*)(xn + off + bj * HALF + n * 16) = w; }
                asm volatile("" ::: "memory"); }
    }
};

template <class Epi, class Sched, bool ALIGN_EPI = false, bool SP2 = false>
__device__ __forceinline__ void gemm_phase(PG8_LAS unsigned char* lds, const Gemm g, const Sched& S, const Epi& E) {
    const int tid = threadIdx.x, wid = __builtin_amdgcn_readfirstlane(tid >> 6), lane = tid & 63, wr = wid >> 2, wc = wid & 3, fr = lane & 15, fq = lane >> 4;
    const int K = g.K, nt = K / BK;
    unsigned voffA[2], voffB[2];
#pragma unroll
    for (int i = 0; i < 2; ++i) { int R, C; stage_rc(tid * 16 + i * 8192, R, C); const int Rb = Epi::PERM ? ((R & ~31) + perm32(R & 31)) : R;
        voffA[i] = (unsigned)(R * K + C) * 2u; voffB[i] = (unsigned)(Rb * K + C) * 2u; }
    const size_t kstep = (size_t)(BK * 2);
    const size_t hstep = (size_t)HALF * K * 2;
    const size_t tstep = 2 * hstep;
    const unsigned ldsw = (unsigned)wid * 1024u;
    const int aoff = lds_byte(wr * 64 + fr, fq * 8), boff = lds_byte(wc * 32 + fr, fq * 8);
#define PG8_SA(b, h) (((b) * 2 + (h)) * HTB)
#define PG8_SB(b, h) ((4 + (b) * 2 + (h)) * HTB)
#define PG8_STAGE(bufoff, gbase, voff) do { _Pragma("unroll") for (int _i = 0; _i < 2; ++_i) \
        __builtin_amdgcn_global_load_lds((const unsigned*)((const char*)(gbase) + (voff)[_i]), (PG8_LAS unsigned*)(lds + (bufoff) + ldsw + _i * 8192), 16, 0, 0); } while (0)
#define PG8_LDA(dst, b, h) do { _Pragma("unroll") for (int m = 0; m < 4; ++m) _Pragma("unroll") for (int k = 0; k < 2; ++k) dst[m][k] = *(const PG8_LAS bf16x8*)(lds + PG8_SA(b, h) + aoff + m * 2048 + k * 1024); } while (0)
#define PG8_LDB(dst, b, h) do { _Pragma("unroll") for (int n = 0; n < 2; ++n) _Pragma("unroll") for (int k = 0; k < 2; ++k) dst[n][k] = *(const PG8_LAS bf16x8*)(lds + PG8_SB(b, h) + boff + n * 2048 + k * 1024); } while (0)
#define PG8_MMA(ai, bj, At, Bt) do { __builtin_amdgcn_s_setprio(1); _Pragma("unroll") for (int m = 0; m < 4; ++m) _Pragma("unroll") for (int n = 0; n < 2; ++n) _Pragma("unroll") for (int k = 0; k < 2; ++k) \
        acc[ai][bj][m][n] = __builtin_amdgcn_mfma_f32_16x16x32_bf16(Bt[n][k], At[m][k], acc[ai][bj][m][n], 0, 0, 0); __builtin_amdgcn_s_setprio(0); } while (0)
#define PG8_WAIT_V(n) asm volatile("s_waitcnt vmcnt(" #n ")" ::: "memory")
#define PG8_WAIT_L(n) asm volatile("s_waitcnt lgkmcnt(" #n ")" ::: "memory")
#define PG8_BAR __builtin_amdgcn_s_barrier()
#define PG8_SCHED __builtin_amdgcn_sched_barrier(0)
    Unit cur, nxt; int ui = 0;
    if (!S.next(0, cur)) return;
    f32x4 acc[2][2][4][2];
#pragma unroll
    for (int a = 0; a < 2; ++a)
#pragma unroll
        for (int b = 0; b < 2; ++b)
#pragma unroll
            for (int m = 0; m < 4; ++m)
#pragma unroll
                for (int n = 0; n < 2; ++n) acc[a][b][m][n] = (f32x4){0.f, 0.f, 0.f, 0.f};
    bf16x8 At[4][2], B0[2][2], B1[2][2];
    const char* cA = (const char*)g.A + (size_t)cur.pm * tstep; const char* cB = (const char*)g.Bt + (size_t)cur.pn * tstep;
    S.a_ready(cur);
    if constexpr (SP2) {
        PG8_STAGE(PG8_SB(0, 0), cB, voffB); PG8_STAGE(PG8_SB(0, 1), cB + hstep, voffB); PG8_STAGE(PG8_SA(0, 0), cA, voffA); PG8_STAGE(PG8_SA(0, 1), cA + hstep, voffA);
        if (wr == 1) PG8_BAR;
        PG8_WAIT_V(2); PG8_BAR;
        PG8_STAGE(PG8_SB(1, 0), cB + kstep, voffB); PG8_STAGE(PG8_SA(1, 0), cA + kstep, voffA); PG8_STAGE(PG8_SB(1, 1), cB + hstep + kstep, voffB);
        PG8_WAIT_V(6); PG8_BAR;
    } else {
        PG8_STAGE(PG8_SB(0, 0), cB, voffB); PG8_STAGE(PG8_SA(0, 0), cA, voffA); PG8_STAGE(PG8_SB(0, 1), cB + hstep, voffB); PG8_STAGE(PG8_SA(0, 1), cA + hstep, voffA);
        if (wr == 1) PG8_BAR;
        PG8_WAIT_V(4); PG8_BAR;
        PG8_STAGE(PG8_SB(1, 0), cB + kstep, voffB); PG8_STAGE(PG8_SA(1, 0), cA + kstep, voffA); PG8_STAGE(PG8_SB(1, 1), cB + hstep + kstep, voffB);
        PG8_WAIT_V(6); PG8_BAR;
    }
    for (;;) {
        const bool has_next = S.next(ui + 1, nxt);
        const char* nA = has_next ? (const char*)g.A + (size_t)nxt.pm * tstep : cA; const char* nB = has_next ? (const char*)g.Bt + (size_t)nxt.pn * tstep : cB;
        for (int t = 0; t < nt; t += 2) {
            const bool last = (t == nt - 2);
            const char* a1 = cA + (size_t)(t + 1) * kstep;
            const char* a2 = last ? nA : cA + (size_t)(t + 2) * kstep; const char* b2 = last ? nB : cB + (size_t)(t + 2) * kstep;
            const char* a3 = a2 + kstep; const char* b3 = b2 + kstep;
            if (last && has_next) S.a_ready(nxt);
            if constexpr (SP2) {
            PG8_LDB(B0, 0, 0); PG8_LDB(B1, 0, 1); PG8_SCHED; PG8_LDA(At, 0, 0); PG8_STAGE(PG8_SA(1, 1), a1 + hstep, voffA);
            PG8_WAIT_V(8); PG8_WAIT_L(0); PG8_BAR; PG8_MMA(0, 0, At, B0); PG8_MMA(0, 1, At, B1); PG8_BAR; PG8_SCHED;
            PG8_LDA(At, 0, 1); PG8_STAGE(PG8_SB(0, 0), b2, voffB); PG8_STAGE(PG8_SB(0, 1), b2 + hstep, voffB); PG8_STAGE(PG8_SA(0, 0), a2, voffA);
            PG8_WAIT_V(8); PG8_WAIT_L(0); PG8_BAR; PG8_MMA(1, 0, At, B0); PG8_MMA(1, 1, At, B1); PG8_BAR; PG8_SCHED;
            PG8_LDB(B0, 1, 0); PG8_LDB(B1, 1, 1); PG8_SCHED; PG8_LDA(At, 1, 0); PG8_STAGE(PG8_SA(0, 1), a2 + hstep, voffA);
            PG8_WAIT_V(8); PG8_WAIT_L(0); PG8_BAR; PG8_MMA(0, 0, At, B0); PG8_MMA(0, 1, At, B1); PG8_BAR; PG8_SCHED;
            PG8_LDA(At, 1, 1); PG8_STAGE(PG8_SB(1, 0), b3, voffB); PG8_STAGE(PG8_SB(1, 1), b3 + hstep, voffB); PG8_STAGE(PG8_SA(1, 0), a3, voffA);
            PG8_WAIT_V(8); PG8_WAIT_L(0); PG8_BAR; PG8_MMA(1, 0, At, B0); PG8_MMA(1, 1, At, B1); PG8_BAR; PG8_SCHED;
            } else {
            PG8_LDB(B0, 0, 0); PG8_SCHED; PG8_LDA(At, 0, 0); PG8_STAGE(PG8_SA(1, 1), a1 + hstep, voffA);
            PG8_WAIT_L(8); PG8_BAR; PG8_WAIT_L(0); PG8_MMA(0, 0, At, B0); PG8_BAR; PG8_SCHED;
            PG8_LDB(B1, 0, 1); PG8_STAGE(PG8_SB(0, 0), b2, voffB);
            PG8_BAR; PG8_WAIT_L(0); PG8_MMA(0, 1, At, B1); PG8_BAR;
            PG8_LDA(At, 0, 1); PG8_STAGE(PG8_SA(0, 0), a2, voffA);
            PG8_BAR; PG8_WAIT_L(0); PG8_MMA(1, 0, At, B0); PG8_BAR; PG8_SCHED;
            PG8_STAGE(PG8_SB(0, 1), b2 + hstep, voffB);
            PG8_WAIT_V(6); PG8_BAR; PG8_MMA(1, 1, At, B1); PG8_BAR;
            PG8_LDB(B0, 1, 0); PG8_SCHED; PG8_LDA(At, 1, 0); PG8_STAGE(PG8_SA(0, 1), a2 + hstep, voffA);
            PG8_WAIT_L(8); PG8_BAR; PG8_WAIT_L(0); PG8_MMA(0, 0, At, B0); PG8_BAR; PG8_SCHED;
            PG8_LDB(B1, 1, 1); PG8_STAGE(PG8_SB(1, 0), b3, voffB);
            PG8_BAR; PG8_WAIT_L(0); PG8_MMA(0, 1, At, B1); PG8_BAR;
            PG8_LDA(At, 1, 1); PG8_STAGE(PG8_SA(1, 0), a3, voffA);
            PG8_BAR; PG8_WAIT_L(0); PG8_MMA(1, 0, At, B0); PG8_BAR; PG8_SCHED;
            PG8_STAGE(PG8_SB(1, 1), b3 + hstep, voffB);
            PG8_WAIT_V(6); PG8_BAR; PG8_MMA(1, 1, At, B1); PG8_BAR;
            }
        }
        if constexpr (ALIGN_EPI) { if (wr == 0) PG8_BAR; }
        if constexpr (!Epi::AFTER_DRAIN) { E(acc, cur, wr, wc, fr, fq); S.done(cur); }
        if (!has_next) break;
#pragma unroll
        for (int a = 0; a < 2; ++a)
#pragma unroll
            for (int b = 0; b < 2; ++b)
#pragma unroll
                for (int m = 0; m < 4; ++m)
#pragma unroll
                    for (int n = 0; n < 2; ++n) acc[a][b][m][n] = (f32x4){0.f, 0.f, 0.f, 0.f};
        cur = nxt; cA = nA; cB = nB; ++ui;
        if constexpr (ALIGN_EPI) { if (wr == 1) PG8_BAR; }
    }
    PG8_WAIT_V(0);
    if constexpr (!ALIGN_EPI) { if (wr == 0) PG8_BAR; }
    PG8_BAR;
    if constexpr (Epi::AFTER_DRAIN) { E.fused(acc, cur, wr, wc, fr, fq, lds, wid, lane); S.done(cur); }
#undef PG8_SA
#undef PG8_SB
#undef PG8_STAGE
#undef PG8_LDA
#undef PG8_LDB
#undef PG8_MMA
#undef PG8_WAIT_V
#undef PG8_WAIT_L
#undef PG8_BAR
#undef PG8_SCHED
}
}
namespace pg8 {
struct EpiF32 {
    static constexpr bool PERM = false, AFTER_DRAIN = false;
    float* C; int ldc;
    __device__ __forceinline__ void operator()(const f32x4 (&acc)[2][2][4][2], const Unit& u, int wr, int wc, int fr, int fq) const {
        const int row0 = u.pm * BM + wr * 64 + fr, col0 = u.pn * BM + wc * 32 + 4 * fq;
#pragma unroll
        for (int ai = 0; ai < 2; ++ai)
#pragma unroll
            for (int m = 0; m < 4; ++m) { float* rowp = C + (size_t)(row0 + ai * HALF + m * 16) * ldc + col0;
#pragma unroll
                for (int bj = 0; bj < 2; ++bj)
#pragma unroll
                    for (int n = 0; n < 2; ++n) *(f32x4*)(rowp + bj * HALF + n * 16) = acc[ai][bj][m][n]; }
    }
};
struct EpiB16 {
    static constexpr bool PERM = true, AFTER_DRAIN = false;
    bf16_t* O; int ldc;
    __device__ __forceinline__ void operator()(const f32x4 (&acc)[2][2][4][2], const Unit& u, int wr, int wc, int fr, int fq) const {
        const int row0 = u.pm * BM + wr * 64 + fr, col0 = u.pn * BM + wc * 32 + 8 * fq;
#pragma unroll
        for (int ai = 0; ai < 2; ++ai)
#pragma unroll
            for (int m = 0; m < 4; ++m) { bf16_t* rowp = O + (size_t)(row0 + ai * HALF + m * 16) * ldc + col0;
#pragma unroll
                for (int bj = 0; bj < 2; ++bj) { const f32x4 v0 = acc[ai][bj][m][0], v1 = acc[ai][bj][m][1];
                    u32x4 w; w.x = cvt_pk_bf16(v0[0], v0[1]); w.y = cvt_pk_bf16(v0[2], v0[3]); w.z = cvt_pk_bf16(v1[0], v1[1]); w.w = cvt_pk_bf16(v1[2], v1[3]);
                    *(u32x4*)(rowp + bj * HALF) = w; } }
    }
};
__device__ __forceinline__ float silu_f(float g) { return g * __builtin_amdgcn_rcpf(1.0f + __builtin_amdgcn_exp2f(-1.4426950408889634f * g)); }
struct EpiSwiGLU {
    static constexpr bool PERM = true, AFTER_DRAIN = false;
    bf16_t* H; int ldh;
    __device__ __forceinline__ void operator()(const f32x4 (&acc)[2][2][4][2], const Unit& u, int wr, int wc, int fr, int fq) const {
        const int row0 = u.pm * BM + wr * 64 + fr, col0 = u.pn * HALF + wc * 32 + 8 * fq;
#pragma unroll
        for (int ai = 0; ai < 2; ++ai)
#pragma unroll
            for (int m = 0; m < 4; ++m) { bf16_t* rowp = H + (size_t)(row0 + ai * HALF + m * 16) * ldh + col0;
                const f32x4 g0 = acc[ai][0][m][0], g1 = acc[ai][0][m][1], u0 = acc[ai][1][m][0], u1 = acc[ai][1][m][1];
                u32x4 w; w.x = cvt_pk_bf16(silu_f(g0[0]) * u0[0], silu_f(g0[1]) * u0[1]); w.y = cvt_pk_bf16(silu_f(g0[2]) * u0[2], silu_f(g0[3]) * u0[3]);
                w.z = cvt_pk_bf16(silu_f(g1[0]) * u1[0], silu_f(g1[1]) * u1[1]); w.w = cvt_pk_bf16(silu_f(g1[2]) * u1[2], silu_f(g1[3]) * u1[3]);
                *(u32x4*)rowp = w; }
    }
};
}

constexpr int NWAVES = 8, NTHREADS = 512;
constexpr int BATCH = 8, SEQ = 2048, DM = 1024, MTOK = BATCH * SEQ, DFF = 2816;
constexpr int AW = 512, AH = 8, AHD = 64, WLORA = 64, ALORA = 64, GLORA = 128, APROJ = 3 * AW + WLORA + ALORA + GLORA  ;
constexpr int BW = 512, BBLK = 8, BBD = 64, INPROJ = APROJ + 2 * BW  ;
constexpr int CH = 16, CHD = 64;
constexpr float NORM_EPS = 1e-6f, GN_EPS = 64e-5f;
constexpr int TCH = 128, NCHUNK = SEQ / TCH;

constexpr size_t MiB = 1u << 20;
constexpr size_t WS_CTL = 0;
constexpr int W_L0F1_1 = 2, W_L0F1_2 = 13, W_L0_IN = 19, W_L0_OUT = 25, W_L0F2_1 = 27, W_L0F2_2 = 38, W_L1F1_1 = 44, W_L1F1_2 = 55, W_L1_QKV = 61, W_L1_OUT = 67, W_L1F2_1 = 69, W_L1F2_2 = 80;
constexpr int R_BIG = 86, R_XN = 182, R_FREE = 214, R_END = 256;
constexpr int F_SCANIN = 0  , F_LRUIN = 12  , F_YRAW = 16  , F_LRUH = 18  , F_G = 20  , F_BONUS = 22  , F_STATE = 23  , F_LSTATE = 24;
constexpr size_t CTL_ZERO_BYTES = 1 * MiB;

typedef unsigned short bf16;
typedef float f32x4 __attribute__((ext_vector_type(4)));
typedef unsigned u32x4v __attribute__((ext_vector_type(4)));
typedef unsigned u32x2v __attribute__((ext_vector_type(2)));
#define LAS __attribute__((address_space(3)))

__device__ __forceinline__ unsigned f2bf(float f) { unsigned u = __builtin_bit_cast(unsigned, f); return (u + 0x7fffu + ((u >> 16) & 1u)) >> 16; }
__device__ __forceinline__ unsigned pk2(float lo, float hi) { return f2bf(lo) | (f2bf(hi) << 16); }
__device__ __forceinline__ float bf2f(unsigned b) { return __builtin_bit_cast(float, b << 16); }
__device__ __forceinline__ float wave_sum(float v) {
#pragma unroll
    for (int o = 1; o < 64; o <<= 1) v += __shfl_xor(v, o);
    return v;
}
__device__ __forceinline__ float softplus_f(float x) { return fmaxf(x, 0.f) + log1pf(expf(-fabsf(x))); }
__device__ __forceinline__ float sigmoid_f(float x) { return 1.0f / (1.0f + expf(-x)); }
__device__ __forceinline__ float gelu_tanh_f(float x) { const float u = 0.7978845608028654f * (x + 0.044715f * x * x * x); return 0.5f * x * (1.0f + tanhf(u)); }

enum OpKind { OP_CONV = 0, OP_ROWS = 1, OP_GEMM = 2, OP_PREP = 3, OP_SCAN = 4, OP_POST = 5, OP_ATTN = 6 };
enum { RM_COPY = 1, RM_RES = 2, RM_NORM = 4 };
enum { EPI_F32 = 0, EPI_B16 = 1, EPI_SWIGLU = 2 };
struct Op { int kind; int a, b, c, d, e, f, g; };
constexpr int MAX_OPS = 96;
struct Args { const float* in[43]; float* out; unsigned char* ws; int op_lo, op_hi; Op ops[MAX_OPS]; };

constexpr int LDSCTL_OFF = 131072, MISC_OFF = LDSCTL_OFF + 320, INTAB_OFF = LDSCTL_OFF + 512;
struct InTab { LAS const unsigned long long* t; __device__ __forceinline__ const float* operator[](int k) const { return (const float*)t[k]; } };
struct Ctx {
    LAS unsigned char* lds;
    InTab in; float* xres; unsigned char* ws;
    int tid, lane, wave, G, bid;
};

__device__ __forceinline__ void conv_item(const float* W, int K, int N, bf16* WT, int mode, LAS float* scr, int item, int lane) {
    const int nblk = N / 32, kb = item / nblk, nb = item % nblk, k0 = 64 * kb, n0 = 32 * nb;
#pragma unroll 8
    for (int i = 0; i < 32; ++i) { const int kk = 2 * i + (lane >> 5); scr[kk * 33 + (lane & 31)] = W[(size_t)(k0 + kk) * N + n0 + (lane & 31)]; }
    asm volatile("s_waitcnt lgkmcnt(0)" ::: "memory");
    int r0 = n0;
    if (mode == 1) { const int up = n0 >= DFF ? 1 : 0, j = n0 - up * DFF; r0 = (j >> 7) * 256 + up * 128 + (j & 127); }
    const int c = lane & 7;
#pragma unroll
    for (int j = 0; j < 4; ++j) { const int n = (lane >> 3) + 8 * j; const LAS float* s = scr + (8 * c) * 33 + n;
        u32x4v o; o.x = pk2(s[0 * 33], s[1 * 33]); o.y = pk2(s[2 * 33], s[3 * 33]); o.z = pk2(s[4 * 33], s[5 * 33]); o.w = pk2(s[6 * 33], s[7 * 33]);
        *(u32x4v*)(WT + (size_t)(r0 + n) * K + k0 + 8 * c) = o; }
    asm volatile("s_waitcnt lgkmcnt(0)" ::: "memory");
}
struct ConvDesc { int in_idx, K, N, dst, mode; };
__constant__ ConvDesc CONV_TAB[12] = { {3, DM, 2 * DFF, W_L0F1_1, 1}, {4, DFF, DM, W_L0F1_2, 0}, {7, DM, INPROJ, W_L0_IN, 0}, {26, DM, DM, W_L0_OUT, 0},
                             {29, DM, 2 * DFF, W_L0F2_1, 1}, {30, DFF, DM, W_L0F2_2, 0}, {33, DM, 2 * DFF, W_L1F1_1, 1}, {34, DFF, DM, W_L1F1_2, 0},
                             {37, DM, 3 * DM, W_L1_QKV, 0}, {38, DM, DM, W_L1_OUT, 0}, {41, DM, 2 * DFF, W_L1F2_1, 1}, {42, DFF, DM, W_L1F2_2, 0} };
__device__ __forceinline__ void op_conv(const Ctx& C) {
    const ConvDesc* D = CONV_TAB;
    LAS float* scr = (LAS float*)(C.lds + C.wave * 16384);
    const int gw = C.bid * NWAVES + C.wave, NGW = C.G * NWAVES;
    int base = 0;
#pragma unroll 1
    for (int d = 0; d < 12; ++d) {
        const int K = D[d].K, N = D[d].N, nit = (K / 64) * (N / 32);
        const float* W = C.in[D[d].in_idx]; bf16* WT = (bf16*)(C.ws + (size_t)D[d].dst * MiB);
        int it = ((gw - base) % NGW + NGW) % NGW;
#pragma unroll 1
        for (; it < nit; it += NGW) conv_item(W, K, N, WT, D[d].mode, scr, it, C.lane);
        base += nit;
    }
}

__device__ __forceinline__ void op_rows(const Ctx& C, const Op& op) {
    const int mode = op.a; const float coef = 0.5f * (float)op.c;
    const float* Y = (const float*)(C.ws + (size_t)op.b * MiB);
    const float* gpost = C.in[op.d]; const float* gpre = C.in[op.e];
    bf16* XN = (bf16*)(C.ws + (size_t)R_XN * MiB);
    const float* xsrc = (mode & RM_COPY) ? C.in[0] : C.xres;
    const int gw = C.bid * NWAVES + C.wave, NGW = C.G * NWAVES;
#pragma unroll 1
    for (int m = gw; m < MTOK; m += NGW) {
        const f32x4* xr = (const f32x4*)(xsrc + (size_t)m * DM) + C.lane;
        f32x4 v[4];
#pragma unroll
        for (int j = 0; j < 4; ++j) v[j] = xr[64 * j];
        if (mode & RM_RES) {
            const f32x4* yr = (const f32x4*)(Y + (size_t)m * DM) + C.lane; f32x4 y[4]; float s = 0.f;
#pragma unroll
            for (int j = 0; j < 4; ++j) { y[j] = yr[64 * j]; s += (y[j].x * y[j].x + y[j].y * y[j].y) + (y[j].z * y[j].z + y[j].w * y[j].w); }
            const float rstd = coef / sqrtf(wave_sum(s) * (1.f / DM) + NORM_EPS);
#pragma unroll
            for (int j = 0; j < 4; ++j) { const f32x4 g = ((const f32x4*)gpost)[C.lane + 64 * j]; v[j] = v[j] + y[j] * g * rstd; }
        }
        if (mode & (RM_RES | RM_COPY)) { f32x4* xo = (f32x4*)(C.xres + (size_t)m * DM) + C.lane;
#pragma unroll
            for (int j = 0; j < 4; ++j) xo[64 * j] = v[j]; }
        if (mode & RM_NORM) {
            float s = 0.f;
#pragma unroll
            for (int j = 0; j < 4; ++j) s += (v[j].x * v[j].x + v[j].y * v[j].y) + (v[j].z * v[j].z + v[j].w * v[j].w);
            const float rstd = 1.0f / sqrtf(wave_sum(s) * (1.f / DM) + NORM_EPS);
            u32x2v* o8 = (u32x2v*)(XN + (size_t)m * DM) + C.lane;
#pragma unroll
            for (int j = 0; j < 4; ++j) { const f32x4 g = ((const f32x4*)gpre)[C.lane + 64 * j]; const f32x4 o = v[j] * g * rstd; u32x2v w; w.x = pk2(o.x, o.y); w.y = pk2(o.z, o.w); o8[64 * j] = w; }
        }
    }
}

__device__ __forceinline__ void op_gemm(const Ctx& C, const Op& op) {
    pg8::Gemm g{(const pg8::bf16_t*)(C.ws + (size_t)op.a * MiB), (const pg8::bf16_t*)(C.ws + (size_t)op.b * MiB), MTOK, op.c, op.d};
    pg8::StaticOrder S; S.init(MTOK, op.c, C.G, C.bid);
    void* dst = (void*)(C.ws + (size_t)op.f * MiB);
    if (op.e == EPI_F32) { pg8::EpiF32 E{(float*)dst, op.g}; pg8::gemm_phase<pg8::EpiF32, pg8::StaticOrder, true, true>(C.lds, g, S, E); }
    else if (op.e == EPI_B16) { pg8::EpiB16 E{(pg8::bf16_t*)dst, op.g}; pg8::gemm_phase<pg8::EpiB16, pg8::StaticOrder, true, true>(C.lds, g, S, E); }
    else { pg8::EpiSwiGLU E{(pg8::bf16_t*)dst, op.g}; pg8::gemm_phase<pg8::EpiSwiGLU, pg8::StaticOrder, true, true>(C.lds, g, S, E); }
}

__device__ __forceinline__ void op_prep(const Ctx& C, const Op& op) {
    const int chunk = op.a, j = C.tid;
    const bf16* proj = (const bf16*)(C.ws + (size_t)R_BIG * MiB);
    unsigned char* fr = C.ws + (size_t)R_FREE * MiB;
    float* scanin = (float*)(fr + (size_t)F_SCANIN * MiB); float* lruin = (float*)(fr + (size_t)F_LRUIN * MiB);
    float* gbuf = (float*)(fr + (size_t)F_G * MiB); float* bonus = (float*)(fr + (size_t)F_BONUS * MiB);
    const float* mu = C.in[8]; const float* w0 = C.in[9]; const float* w2 = C.in[10]; const float* a0 = C.in[11]; const float* a2 = C.in[12]; const float* g2 = C.in[13];
    const float* k_k = C.in[14]; const float* k_a = C.in[15]; const float* r_k = C.in[16];
    const float* conv_w = C.in[19]; const float* conv_b = C.in[20]; const float* gaw = C.in[21]; const float* gab = C.in[22]; const float* gxw = C.in[23]; const float* gxb = C.in[24]; const float* lam = C.in[25];
    LAS float* rows = (LAS float*)C.lds;
    LAS float* lin = rows + 7 * INPROJ;
    LAS float* xcs = lin + 4 * 256;
#pragma unroll 1
    for (int grp = C.bid; grp < (BATCH * TCH) / 4; grp += C.G) {
        const int i0 = grp * 4, b = i0 / TCH, tt0 = i0 % TCH, t0 = chunk * TCH + tt0;
        __syncthreads();
        for (int e = C.tid; e < 7 * INPROJ; e += NTHREADS) { const int rr = e / INPROJ, col = e % INPROJ, t = t0 - 3 + rr;
            rows[e] = (t >= 0) ? bf2f(proj[((size_t)(b * SEQ + t)) * INPROJ + col]) : 0.f; }
        __syncthreads();
        for (int e = C.tid; e < 4 * 256; e += NTHREADS) { const int tk = e >> 8, i = e & 255, col = 3 * AW + i;
            const float cur = rows[(3 + tk) * INPROJ + col], prv = rows[(2 + tk) * INPROJ + col]; const float s = cur + mu[col] * (prv - cur);
            lin[e] = (i < 64) ? tanhf(s) : (i < 128 ? s : sigmoid_f(s)); }
#pragma unroll
        for (int tk = 0; tk < 4; ++tk) { float a = conv_b[j];
#pragma unroll
            for (int i = 0; i < 4; ++i) a += rows[(tk + i) * INPROJ + APROJ + j] * conv_w[i * BW + j];
            xcs[tk * 512 + j] = a; }
        __syncthreads();
        float wp[4], ap[4], gg[4], ra[4], ix[4];
#pragma unroll
        for (int tk = 0; tk < 4; ++tk) { wp[tk] = w0[j]; ap[tk] = a0[j]; gg[tk] = 0.f; ra[tk] = gab[j]; ix[tk] = gxb[j]; }
#pragma unroll 4
        for (int i = 0; i < 64; ++i) { const float ww = w2[i * AW + j], aa = a2[i * AW + j];
#pragma unroll
            for (int tk = 0; tk < 4; ++tk) { wp[tk] += lin[tk * 256 + i] * ww; ap[tk] += lin[tk * 256 + 64 + i] * aa; } }
#pragma unroll 4
        for (int i = 0; i < 128; ++i) { const float gw_ = g2[i * AW + j];
#pragma unroll
            for (int tk = 0; tk < 4; ++tk) gg[tk] += lin[tk * 256 + 128 + i] * gw_; }
        { const int n = j >> 6, jj = j & 63;
#pragma unroll 4
          for (int i = 0; i < 64; ++i) { const float wa = gaw[(n * 64 + i) * 64 + jj], wx = gxw[(n * 64 + i) * 64 + jj];
#pragma unroll
            for (int tk = 0; tk < 4; ++tk) { const float xv = xcs[tk * 512 + n * 64 + i]; ra[tk] += xv * wa; ix[tk] += xv * wx; } } }
        const int h = j >> 6, jj = j & 63;
#pragma unroll
        for (int tk = 0; tk < 4; ++tk) {
            const int tt = tt0 + tk;
            const LAS float* cur = rows + (3 + tk) * INPROJ; const LAS float* prv = rows + (2 + tk) * INPROJ;
            const float r = cur[j] + mu[j] * (prv[j] - cur[j]);
            const float k = cur[AW + j] + mu[AW + j] * (prv[AW + j] - cur[AW + j]);
            const float v = cur[2 * AW + j] + mu[2 * AW + j] * (prv[2 * AW + j] - cur[2 * AW + j]);
            const float wlog = -softplus_f(-wp[tk]) - 0.5f; const float decay = expf(-expf(wlog));
            const float a = sigmoid_f(ap[tk]);
            const float kkr = k * k_k[j]; const float ss = wave_sum(kkr * kkr); const float kk = kkr / fmaxf(sqrtf(ss), 1e-12f);
            const float kh = k * (1.0f + (a - 1.0f) * k_a[j]);
            const float bo = wave_sum(r * kh * r_k[j]);
            float* si = scanin + ((size_t)((b * AH + h) * TCH + tt)) * 384;
            si[0 * 64 + jj] = kk; si[1 * 64 + jj] = decay; si[2 * 64 + jj] = kk * a; si[3 * 64 + jj] = kh; si[4 * 64 + jj] = r; si[5 * 64 + jj] = v;
            gbuf[((size_t)(b * TCH + tt)) * AW + j] = gg[tk];
            if (jj == 0) bonus[(b * TCH + tt) * AH + h] = bo;
            const float rg = sigmoid_f(ra[tk]), ig = sigmoid_f(ix[tk]);
            const float log_a = -8.0f * rg * softplus_f(-lam[j]);
            const float al = expf(log_a), mult = sqrtf(-expm1f(2.0f * log_a));
            float* li = lruin + ((size_t)(b * TCH + tt)) * 1024;
            li[j] = al; li[512 + j] = mult * ig * xcs[tk * 512 + j];
        }
    }
}

template <int CTRL> __device__ __forceinline__ float dppx(float v) { return __builtin_bit_cast(float, __builtin_amdgcn_update_dpp(0, __builtin_bit_cast(int, v), CTRL, 0xF, 0xF, true)); }
__device__ __forceinline__ float sum16(float v) { v += dppx<0xB1>(v); v += dppx<0x4E>(v); v += dppx<0x141>(v); v += dppx<0x140>(v); return v; }
constexpr int SUBT = 32, NSUB = TCH / SUBT, SUBF = SUBT * 384;
typedef __attribute__((address_space(1))) float gfloat;
typedef __attribute__((address_space(1))) f32x4 gf32x4;
struct ScanOps { f32x4 kk, w, kka, kh, r; float v; };
__device__ __forceinline__ void scan_load(ScanOps& o, const LAS float* p, int k0, int row) {
    o.kk = *(const LAS f32x4*)(p + k0); o.w = *(const LAS f32x4*)(p + 64 + k0); o.kka = *(const LAS f32x4*)(p + 128 + k0); o.kh = *(const LAS f32x4*)(p + 192 + k0); o.r = *(const LAS f32x4*)(p + 256 + k0); o.v = p[320 + row];
}
__device__ __forceinline__ float scan_step(f32x4& S, const ScanOps& o) {
    const float sa = -sum16((S.x * o.kk.x + S.y * o.kk.y) + (S.z * o.kk.z + S.w * o.kk.w));
    S = S * o.w + (o.kka * sa + o.kh * o.v);
    return sum16((S.x * o.r.x + S.y * o.r.y) + (S.z * o.r.z + S.w * o.r.w));
}
__device__ __forceinline__ void op_scan(const Ctx& C, const Op& op) {
    const int chunk = op.a;
    unsigned char* fr = C.ws + (size_t)R_FREE * MiB;
    const gfloat* scanin = (const gfloat*)(fr + (size_t)F_SCANIN * MiB); const gfloat* lruin = (const gfloat*)(fr + (size_t)F_LRUIN * MiB);
    gfloat* yraw = (gfloat*)(fr + (size_t)F_YRAW * MiB); gfloat* lruh = (gfloat*)(fr + (size_t)F_LRUH * MiB);
    gfloat* state = (gfloat*)(fr + (size_t)F_STATE * MiB); gfloat* lstate = (gfloat*)(fr + (size_t)F_LSTATE * MiB);
    LAS float* buf = (LAS float*)C.lds;
#pragma unroll 1
    for (int item = C.bid; item < BATCH * AH * 4; item += C.G) {
        const int bh = item >> 2, vg = item & 3, b = bh >> 3, h = bh & 7;
        const gfloat* si = scanin + (size_t)bh * TCH * 384;
        __syncthreads();
#pragma unroll
        for (int i = 0; i < 6; ++i) ((LAS f32x4*)buf)[i * 512 + C.tid] = ((const gf32x4*)si)[i * 512 + C.tid];
        __syncthreads();
        const int lrow = (C.wave & 3) * 4 + (C.lane >> 4), row = vg * 16 + lrow, k0 = 4 * (C.lane & 15), l15 = C.lane & 15;
        f32x4 S = (f32x4){0.f, 0.f, 0.f, 0.f};
        gfloat* sp = state + ((size_t)(bh * 64 + row)) * 64 + k0;
        const int c = h * 64 + C.lane;
        float hs = 0.f;
        if (chunk > 0) { if (C.wave < 4) S = *(const gf32x4*)sp; else if (C.wave == 4 && vg == 0) hs = lstate[b * BW + c]; }
#pragma unroll 1
        for (int sub = 0; sub < NSUB; ++sub) {
            const LAS float* cur = buf + (sub & 1) * SUBF;
            if (C.wave >= 4) {
                if (sub + 1 < NSUB) { LAS f32x4* dst = (LAS f32x4*)(buf + ((sub + 1) & 1) * SUBF); const gf32x4* src = (const gf32x4*)(si + (size_t)(sub + 1) * SUBF); const int ti = C.tid - 256;
#pragma unroll
                    for (int i = 0; i < 12; ++i) dst[i * 256 + ti] = src[i * 256 + ti]; }
                if (C.wave == 4 && vg == 0) {
                    const gfloat* li = lruin + ((size_t)(b * TCH + sub * SUBT)) * 1024 + c; gfloat* lo = lruh + ((size_t)(b * TCH + sub * SUBT)) * BW + c;
                    float av[SUBT], uv[SUBT];
#pragma unroll
                    for (int i = 0; i < SUBT; ++i) { av[i] = li[i * 1024]; uv[i] = li[i * 1024 + 512]; }
#pragma unroll
                    for (int i = 0; i < SUBT; ++i) { hs = av[i] * hs + uv[i]; lo[i * BW] = hs; }
                }
            } else {
                gfloat* yo = yraw + ((size_t)(b * TCH + sub * SUBT + l15)) * AW + h * 64 + row;
                ScanOps o0, o1;
                scan_load(o0, cur, k0, lrow + vg * 16);
#pragma unroll
                for (int half = 0; half < 2; ++half) {
                    float yv = 0.f;
#pragma unroll
                    for (int t2 = 0; t2 < 16; t2 += 2) {
                        const int tt = half * 16 + t2;
                        scan_load(o1, cur + (tt + 1) * 384, k0, lrow + vg * 16);
                        const float ya = scan_step(S, o0); yv = (l15 == t2) ? ya : yv;
                        if (tt + 2 < SUBT) scan_load(o0, cur + (tt + 2) * 384, k0, lrow + vg * 16);
                        const float yb = scan_step(S, o1); yv = (l15 == t2 + 1) ? yb : yv;
                    }
                    yo[(size_t)half * 16 * AW] = yv;
                }
            }
            __syncthreads();
        }
        if (C.wave < 4) *(gf32x4*)sp = S; else if (C.wave == 4 && vg == 0) lstate[b * BW + c] = hs;
    }
}

__device__ __forceinline__ void op_post(const Ctx& C, const Op& op) {
    const int chunk = op.a, j = C.tid, h = j >> 6, jj = j & 63;
    const bf16* proj = (const bf16*)(C.ws + (size_t)R_BIG * MiB);
    unsigned char* fr = C.ws + (size_t)R_FREE * MiB;
    const float* scanin = (const float*)(fr + (size_t)F_SCANIN * MiB);
    const float* yraw = (const float*)(fr + (size_t)F_YRAW * MiB); const float* lruh = (const float*)(fr + (size_t)F_LRUH * MiB);
    const float* gbuf = (const float*)(fr + (size_t)F_G * MiB); const float* bonus = (const float*)(fr + (size_t)F_BONUS * MiB);
    const float* lnx_g = C.in[17]; const float* lnx_b = C.in[18];
    bf16* AO = (bf16*)(C.ws + (size_t)R_XN * MiB);
#pragma unroll 1
    for (int i = C.bid; i < BATCH * TCH; i += C.G) {
        const int b = i / TCH, tt = i % TCH, t = chunk * TCH + tt; const size_t m = (size_t)b * SEQ + t;
        const float y = yraw[(size_t)i * AW + j];
        const float mean = wave_sum(y) * (1.f / 64.f); const float d = y - mean; const float var = wave_sum(d * d) * (1.f / 64.f);
        const float yn = d * (1.0f / sqrtf(var + GN_EPS)) * lnx_g[j] + lnx_b[j];
        const float v = scanin[((size_t)((b * AH + h) * TCH + tt)) * 384 + 320 + jj];
        const float ya = (yn + bonus[i * AH + h] * v) * gbuf[(size_t)i * AW + j];
        const float gb = bf2f(proj[m * INPROJ + APROJ + BW + j]);
        const float yb = lruh[(size_t)i * BW + j] * gelu_tanh_f(gb);
        AO[m * DM + j] = (bf16)f2bf(ya); AO[m * DM + AW + j] = (bf16)f2bf(yb);
    }
}

__device__ __forceinline__ void op_attn(const Ctx& C, const Op& op) {
    const bf16* QKV = (const bf16*)(C.ws + (size_t)R_BIG * MiB);
    bf16* O = (bf16*)(C.ws + (size_t)R_XN * MiB);
    LAS float* Ks = (LAS float*)C.lds;
    LAS float* Vs = Ks + 64 * 64;
#pragma unroll 1
    for (int item = C.bid; item < BATCH * CH * 4; item += C.G) {
        const int qb = 3 - (item & 3), bh = item >> 2, b = bh >> 4, h = bh & 15;
        const int q = qb * 512 + C.wave * 64 + C.lane; const size_t mq = (size_t)b * SEQ + q;
        float qv[64], o[64];
#pragma unroll
        for (int d8 = 0; d8 < 8; ++d8) { const u32x4v w = *(const u32x4v*)(QKV + mq * 3072 + h * 64 + d8 * 8);
            qv[d8 * 8 + 0] = bf2f(w.x & 0xffffu) * 0.125f; qv[d8 * 8 + 1] = bf2f(w.x >> 16) * 0.125f; qv[d8 * 8 + 2] = bf2f(w.y & 0xffffu) * 0.125f; qv[d8 * 8 + 3] = bf2f(w.y >> 16) * 0.125f;
            qv[d8 * 8 + 4] = bf2f(w.z & 0xffffu) * 0.125f; qv[d8 * 8 + 5] = bf2f(w.z >> 16) * 0.125f; qv[d8 * 8 + 6] = bf2f(w.w & 0xffffu) * 0.125f; qv[d8 * 8 + 7] = bf2f(w.w >> 16) * 0.125f; }
#pragma unroll
        for (int d = 0; d < 64; ++d) o[d] = 0.f;
        float carry = 0.f;
        const int ntile = (qb * 512 + 512) / 64;
#pragma unroll 1
        for (int kt = ntile - 1; kt >= 0; --kt) {
            __syncthreads();
            {
                const int key = C.tid >> 3, d8 = C.tid & 7; const size_t mk = (size_t)b * SEQ + kt * 64 + key;
                const u32x4v kw = *(const u32x4v*)(QKV + mk * 3072 + 1024 + h * 64 + d8 * 8), vw = *(const u32x4v*)(QKV + mk * 3072 + 2048 + h * 64 + d8 * 8);
                LAS float* kd = Ks + key * 64 + d8 * 8; LAS float* vd = Vs + key * 64 + d8 * 8;
                kd[0] = bf2f(kw.x & 0xffffu); kd[1] = bf2f(kw.x >> 16); kd[2] = bf2f(kw.y & 0xffffu); kd[3] = bf2f(kw.y >> 16); kd[4] = bf2f(kw.z & 0xffffu); kd[5] = bf2f(kw.z >> 16); kd[6] = bf2f(kw.w & 0xffffu); kd[7] = bf2f(kw.w >> 16);
                vd[0] = bf2f(vw.x & 0xffffu); vd[1] = bf2f(vw.x >> 16); vd[2] = bf2f(vw.y & 0xffffu); vd[3] = bf2f(vw.y >> 16); vd[4] = bf2f(vw.z & 0xffffu); vd[5] = bf2f(vw.z >> 16); vd[6] = bf2f(vw.w & 0xffffu); vd[7] = bf2f(vw.w >> 16);
            }
            __syncthreads();
            if (kt * 64 > qb * 512 + C.wave * 64 + 63) continue;
#pragma unroll 1
            for (int kk = 63; kk >= 0; --kk) {
                const int key = kt * 64 + kk;
                const LAS f32x4* kr = (const LAS f32x4*)(Ks + kk * 64);
                float z0 = 0.f, z1 = 0.f;
#pragma unroll
                for (int d4 = 0; d4 < 16; ++d4) { const f32x4 kv = kr[d4]; z0 += qv[4 * d4] * kv.x + qv[4 * d4 + 1] * kv.y; z1 += qv[4 * d4 + 2] * kv.z + qv[4 * d4 + 3] * kv.w; }
                const float z = z0 + z1;
                const bool live = key < q;
                const float sp = live ? softplus_f(z) : 0.f;
                carry += sp;
                const float att = live ? expf(z - carry) : 0.f;
                const LAS f32x4* vr = (const LAS f32x4*)(Vs + kk * 64);
#pragma unroll
                for (int d4 = 0; d4 < 16; ++d4) { const f32x4 vv = vr[d4]; o[4 * d4] += att * vv.x; o[4 * d4 + 1] += att * vv.y; o[4 * d4 + 2] += att * vv.z; o[4 * d4 + 3] += att * vv.w; }
            }
        }
        bf16* op_ = O + mq * DM + h * 64;
#pragma unroll
        for (int d8 = 0; d8 < 8; ++d8) { u32x4v w; w.x = pk2(o[d8 * 8], o[d8 * 8 + 1]); w.y = pk2(o[d8 * 8 + 2], o[d8 * 8 + 3]); w.z = pk2(o[d8 * 8 + 4], o[d8 * 8 + 5]); w.w = pk2(o[d8 * 8 + 6], o[d8 * 8 + 7]); *(u32x4v*)(op_ + d8 * 8) = w; }
    }
}

constexpr int LDS_BYTES = 147456;
#define GAS __attribute__((address_space(1)))
typedef GAS unsigned gu32;
constexpr int CW_BAR = 4096;
#define XB_TMO      128
#define XB_XCNT(j)  (256  + 64 * (j))
#define XB_XSUB(j)  (1280 + 64 * (j))
#define XB_XGEN(j)  (2304 + 64 * (j))
#define XB_TOP      3328
#define XB_TOPGEN   3392
#define XCD_BAR_WORDS 3456
#define XB_SPIN_CAP (1u << 18)

__device__ __forceinline__ unsigned xb_ld(unsigned* p)              { return __hip_atomic_load(p, __ATOMIC_RELAXED, __HIP_MEMORY_SCOPE_AGENT); }
__device__ __forceinline__ unsigned xb_add(unsigned* p, unsigned v) { return __hip_atomic_fetch_add(p, v, __ATOMIC_RELAXED, __HIP_MEMORY_SCOPE_AGENT); }
__device__ __forceinline__ unsigned xb_xcc_id() { return (unsigned)__builtin_amdgcn_s_getreg((3 << 11) | 20) & 0xFu; }
#define XB_SPIN(cond, bar) do { unsigned _sp = 0; while (cond) { __builtin_amdgcn_s_sleep(1); \
    if ((++_sp & 255u) == 0u) { if (xb_ld(&(bar)[XB_TMO])) break; if (_sp > XB_SPIN_CAP) { atomicAdd(&(bar)[XB_TMO], 1u); break; } } } } while (0)

struct XcdBarrier {
    unsigned* bar; unsigned x;
    volatile LAS unsigned* st;
};

__device__ __forceinline__ XcdBarrier xcd_barrier_post(unsigned* bar, volatile LAS unsigned* st) {
    XcdBarrier b; b.bar = bar; b.x = xb_xcc_id(); b.st = st;
    if (threadIdx.x == 0) (void)xb_add(&bar[XB_XCNT(b.x)], 1u);
    return b;
}
__device__ __forceinline__ void xcd_barrier_complete(unsigned* bar, unsigned x, unsigned& nloc, unsigned& nx) {
    const unsigned G = gridDim.x * gridDim.y * gridDim.z;
    unsigned sum, cnt, mine, sp = 0u;
    for (;;) {
        sum = 0u; cnt = 0u; mine = 0u;
#pragma unroll
        for (unsigned j = 0; j < 16; ++j) { const unsigned c = xb_ld(&bar[XB_XCNT(j)]); sum += c; cnt += (c > 0u) ? 1u : 0u; mine = (j == x) ? c : mine; }
        if (sum == G) break;
        __builtin_amdgcn_s_sleep(1);
        if ((++sp & 255u) == 0u) { if (xb_ld(&bar[XB_TMO])) break; if (sp > XB_SPIN_CAP) { atomicAdd(&bar[XB_TMO], 1u); break; } }
    }
    nloc = mine > 0u ? mine : 1u; nx = cnt > 0u ? cnt : 1u;
}

__device__ __forceinline__ void xcd_barrier(const XcdBarrier& b) {
    asm volatile("s_waitcnt vmcnt(0)" ::: "memory");
    __syncthreads();
    if (threadIdx.x == 0) {
        unsigned* bar = b.bar;
        __builtin_amdgcn_s_waitcnt(0);
        unsigned nloc = b.st[0], nx = b.st[1];
        if (nloc == 0u) { xcd_barrier_complete(bar, b.x, nloc, nx); b.st[0] = nloc; b.st[1] = nx; }
        const unsigned old = xb_add(&bar[XB_XSUB(b.x)], 1u);
        const unsigned gen = old / nloc;
        if (old + 1u == (gen + 1u) * nloc) {
            __builtin_amdgcn_fence(__ATOMIC_RELEASE, "agent");
            asm volatile("s_waitcnt vmcnt(0)" ::: "memory");
            const unsigned og = xb_add(&bar[XB_TOP], 1u);
            const unsigned tg = og / nx;
            if (og + 1u == (tg + 1u) * nx) xb_add(&bar[XB_TOPGEN], 1u);
            else XB_SPIN(xb_ld(&bar[XB_TOPGEN]) == tg, bar);
            __builtin_amdgcn_fence(__ATOMIC_ACQUIRE, "agent");
            xb_add(&bar[XB_XGEN(b.x)], 1u);
            asm volatile("s_waitcnt vmcnt(0)" ::: "memory");
        } else {
            XB_SPIN(xb_ld(&bar[XB_XGEN(b.x)]) == gen, bar);
            __builtin_amdgcn_fence(__ATOMIC_ACQUIRE, "agent");
            asm volatile("s_waitcnt vmcnt(0)" ::: "memory");
        }
    }
    __syncthreads();
}


namespace cg = cooperative_groups;
__global__ void __launch_bounds__(NTHREADS, 2) mk_fwd(Args args) {
    extern __shared__ __attribute__((aligned(16))) unsigned char lds[];
    LAS unsigned char* L = (LAS unsigned char*)lds;
    for (int u = threadIdx.x; u < (LDS_BYTES - LDSCTL_OFF) / 4; u += NTHREADS) ((LAS unsigned*)(L + LDSCTL_OFF))[u] = 0u;
    __syncthreads();
    if (threadIdx.x < 43) ((LAS unsigned long long*)(L + INTAB_OFF))[threadIdx.x] = (unsigned long long)args.in[threadIdx.x];
    __syncthreads();
    XcdBarrier bar = xcd_barrier_post((unsigned*)(args.ws + WS_CTL) + CW_BAR, (volatile LAS unsigned*)(L + MISC_OFF) + 8);
    cg::this_grid().sync();
#pragma unroll 1
    for (int oi = args.op_lo; oi < args.op_hi; ++oi) {
        const Op op = args.ops[oi];
        Ctx C;
        { int t = threadIdx.x; asm volatile("" : "+v"(t)); unsigned char* w = args.ws; asm volatile("" : "+s"(w)); float* xo = args.out; asm volatile("" : "+s"(xo));
          C.tid = t; C.lane = t & 63; C.wave = __builtin_amdgcn_readfirstlane(t >> 6); C.ws = w; C.xres = xo; C.G = gridDim.x; C.bid = blockIdx.x;
          C.lds = L; C.in.t = (LAS const unsigned long long*)(L + INTAB_OFF); }
        switch (op.kind) {
            case OP_CONV: op_conv(C); break;
            case OP_ROWS: op_rows(C, op); break;
            case OP_GEMM: op_gemm(C, op); break;
            case OP_PREP: op_prep(C, op); break;
            case OP_SCAN: op_scan(C, op); break;
            case OP_POST: op_post(C, op); break;
            case OP_ATTN: op_attn(C, op); break;
        }
        if (oi + 1 < args.op_hi) xcd_barrier(bar);
    }
}

static int build_ops(Op* ops) {
    int n = 0;
    auto add = [&](int kind, int a = 0, int b = 0, int c = 0, int d = 0, int e = 0, int f = 0, int g = 0) { ops[n++] = Op{kind, a, b, c, d, e, f, g}; };
    auto ffn = [&](int w1, int w2, int gpost, int gpre_next) {
        add(OP_GEMM, R_XN, w1, 2 * DFF, DM, EPI_SWIGLU, R_BIG, DFF);
        add(OP_GEMM, R_BIG, w2, DM, DFF, EPI_F32, R_XN, DM);
        add(OP_ROWS, RM_RES, R_XN, 1, gpost, 0);
        if (gpre_next >= 0) add(OP_ROWS, RM_NORM, 0, 0, 0, gpre_next);
    };
    add(OP_CONV);
    add(OP_ROWS, RM_COPY | RM_NORM, 0, 0, 0, 1);
    ffn(W_L0F1_1, W_L0F1_2, 2, 5);
    add(OP_GEMM, R_XN, W_L0_IN, INPROJ, DM, EPI_B16, R_BIG, INPROJ);
    for (int c = 0; c < NCHUNK; ++c) { add(OP_PREP, c); add(OP_SCAN, c); add(OP_POST, c); }
    add(OP_GEMM, R_XN, W_L0_OUT, DM, DM, EPI_F32, R_BIG, DM);
    add(OP_ROWS, RM_RES | RM_NORM, R_BIG, 2, 6, 27);
    ffn(W_L0F2_1, W_L0F2_2, 28, 31);
    ffn(W_L1F1_1, W_L1F1_2, 32, 35);
    add(OP_GEMM, R_XN, W_L1_QKV, 3 * DM, DM, EPI_B16, R_BIG, 3 * DM);
    add(OP_ATTN);
    add(OP_GEMM, R_XN, W_L1_OUT, DM, DM, EPI_F32, R_BIG, DM);
    add(OP_ROWS, RM_RES | RM_NORM, R_BIG, 2, 36, 39);
    ffn(W_L1F2_1, W_L1F2_2, 40, -1);
    return n;
}

extern "C" void kernel_launch(void* const* d_in, const int* in_sizes, int n_in, void* d_out, int out_size, void* d_ws, size_t ws_size, hipStream_t stream) {
    static int grid = 0;
    if (grid == 0) {
        if (n_in != 43 || in_sizes[0] != MTOK * DM || out_size != MTOK * DM || ws_size < (size_t)R_END * MiB) { fprintf(stderr, "kernel_launch: unexpected shapes (n_in %d, in0 %d, out %d, ws %zu)\n", n_in, n_in > 0 ? in_sizes[0] : -1, out_size, ws_size); grid = -1; return; }
        if (hipFuncSetAttribute((const void*)mk_fwd, hipFuncAttributeMaxDynamicSharedMemorySize, LDS_BYTES) != hipSuccess) { fprintf(stderr, "kernel_launch: hipFuncSetAttribute failed\n"); grid = -1; return; }
        int dev = 0, cus = 0, per_cu = 0;
        if (hipGetDevice(&dev) != hipSuccess || hipDeviceGetAttribute(&cus, hipDeviceAttributeMultiprocessorCount, dev) != hipSuccess) { grid = -1; return; }
        if (hipOccupancyMaxActiveBlocksPerMultiprocessor(&per_cu, (const void*)mk_fwd, NTHREADS, LDS_BYTES) != hipSuccess || per_cu < 1) { fprintf(stderr, "kernel_launch: occupancy query failed (%d)\n", per_cu); grid = -1; return; }
        grid = cus * per_cu;
    }
    if (grid < 0) return;
    if (hipMemsetAsync((char*)d_ws + WS_CTL, 0, CTL_ZERO_BYTES, stream) != hipSuccess) { fprintf(stderr, "kernel_launch: hipMemsetAsync failed\n"); return; }
    Args a{};
    for (int i = 0; i < 43; ++i) a.in[i] = (const float*)d_in[i];
    a.out = (float*)d_out; a.ws = (unsigned char*)d_ws;
    const int nops = build_ops(a.ops);
    a.op_lo = 0; a.op_hi = nops;
    void* kargs[] = {&a};
    const hipError_t e = hipLaunchCooperativeKernel((const void*)mk_fwd, dim3(grid), dim3(NTHREADS), kargs, LDS_BYTES, stream);
    if (e != hipSuccess) fprintf(stderr, "kernel_launch: cooperative launch failed: %s (grid %d)\n", hipGetErrorString(e), grid);
}
```

```cpp
#include <hip/hip_runtime.h>
#include <hip/hip_cooperative_groups.h>
#include <cstdio>
#include <cstdint>
namespace pg8 {
#define PG8_LAS __attribute__((address_space(3)))
typedef unsigned short bf16_t;
typedef short bf16x8 __attribute__((ext_vector_type(8)));
typedef float f32x4 __attribute__((ext_vector_type(4)));
typedef unsigned u32x4 __attribute__((ext_vector_type(4)));
constexpr int BM = 256, BK = 64, HALF = 128, HTB = HALF * BK * 2  , STAGE_BYTES = 8 * HTB, NXCD = 8, WGM = 8;

__host__ __device__ __forceinline__ int lds_byte(int r, int c) { const int st = (r >> 4) * 2 + (c >> 5), rr = r & 15, cc = c & 31, ob = rr * 64 + cc * 2; return st * 1024 + (ob ^ (((ob >> 9) & 1) << 5)); }
__host__ __device__ __forceinline__ void stage_rc(int b, int& R, int& C) { const int st = b / 1024, sb = b % 1024, swz = sb ^ (((sb >> 9) & 1) << 5); R = (st >> 1) * 16 + swz / 64; C = (st & 1) * 32 + (swz % 64) / 2; }
__host__ __device__ __forceinline__ int perm32(int rho) { const int n = rho >> 4, i = rho & 15; return 8 * (i >> 2) + 4 * n + (i & 3); }

struct Unit { int pm, pn; };
struct Gemm { const bf16_t* A; const bf16_t* Bt; int M, N, K; };

struct StaticOrder {
    int nM, nN, nwg, G, c;
    __host__ __device__ void init(int M, int N, int G_, int c_) { nM = M / BM; nN = N / BM; nwg = nM * nN; G = G_; c = c_; }
    __host__ __device__ bool next(int i, Unit& u) const {
        const long L = (long)i * G + c; if (L >= nwg) return false;
        int wgid = (int)L; { const int q = nwg / NXCD, r = nwg % NXCD, xcd = wgid % NXCD, off = wgid / NXCD; wgid = (xcd < r ? xcd * (q + 1) : r * (q + 1) + (xcd - r) * q) + off; }
        const int nig = WGM * nN, gid = wgid / nig, fm = gid * WGM, gsz = (nM - fm) < WGM ? (nM - fm) : WGM;
        u.pm = fm + ((wgid % nig) % gsz); u.pn = (wgid % nig) / gsz; return true;
    }
    __device__ __forceinline__ void a_ready(const Unit&) const {}
    __device__ __forceinline__ void done(const Unit&) const {}
};

__device__ __forceinline__ unsigned cvt_pk_bf16(float lo, float hi) { unsigned r; asm volatile("v_cvt_pk_bf16_f32 %0, %1, %2" : "=v"(r) : "v"(lo), "v"(hi)); return r; }
typedef float f32x2 __attribute__((ext_vector_type(2)));
__device__ __forceinline__ f32x2 gelu_pk(f32x2 v) {
    const f32x2 av = __builtin_elementwise_abs(v), d = av * 0.2316418882f + 1.0f;
    f32x2 t; t.x = __builtin_amdgcn_rcpf(d.x); t.y = __builtin_amdgcn_rcpf(d.y);
    f32x2 q = t * 0.5307027145f + (-0.7265760135f); q = q * t + 0.7107068705f; q = q * t + (-0.142248368f); q = q * t + 0.127414796f; q = q * t;
    const f32x2 s = (v * v) * (-0.72134752044f);
    f32x2 e; e.x = __builtin_amdgcn_exp2f(s.x); e.y = __builtin_amdgcn_exp2f(s.y);
    const f32x2 m = v * (q * e), r = v - m;
    f32x2 o; o.x = v.x < 0.f ? m.x : r.x; o.y = v.y < 0.f ? m.y : r.y; return o;
}

template <int ACT  > struct EpiBf16 {
    static constexpr bool PERM = true, AFTER_DRAIN = false; static_assert(ACT == 0 || ACT == 1, "EpiBf16: ACT is 0 (none) or 1 (gelu_pk)");
    bf16_t* O; int ldc; const float* bias; int split_cols; size_t split_stride; float scale0;
    __device__ __forceinline__ void operator()(const f32x4 (&acc)[2][2][4][2], const Unit& u, int wr, int wc, int fr, int fq) const {
        const int row0 = u.pm * BM + wr * 64 + fr; int colt = u.pn * BM; bf16_t* base = O;
        float sc = 1.f; if (split_cols) { const int t = colt / split_cols; base += (size_t)t * split_stride; colt -= t * split_cols; if (t == 0) sc = scale0; }
        const int col0 = colt + wc * 32 + 8 * fq, bcol0 = u.pn * BM + wc * 32 + 8 * fq;
        f32x4 bv[2][2];
#pragma unroll
        for (int bj = 0; bj < 2; ++bj)
#pragma unroll
            for (int n = 0; n < 2; ++n) bv[bj][n] = bias ? *(const f32x4*)(bias + bcol0 + bj * HALF + 4 * n) : (f32x4){0.f, 0.f, 0.f, 0.f};
#pragma unroll
        for (int ai = 0; ai < 2; ++ai)
#pragma unroll
            for (int m = 0; m < 4; ++m) { bf16_t* rowp = base + (size_t)(row0 + ai * HALF + m * 16) * ldc + col0;
#pragma unroll
                for (int bj = 0; bj < 2; ++bj) { f32x4 v0 = acc[ai][bj][m][0] + bv[bj][0], v1 = acc[ai][bj][m][1] + bv[bj][1];
                    if (ACT == 1) { f32x2 a = gelu_pk((f32x2){v0[0], v0[1]}), b = gelu_pk((f32x2){v0[2], v0[3]}), c = gelu_pk((f32x2){v1[0], v1[1]}), d = gelu_pk((f32x2){v1[2], v1[3]});
                        v0 = (f32x4){a.x, a.y, b.x, b.y}; v1 = (f32x4){c.x, c.y, d.x, d.y}; }
                    v0 = v0 * sc; v1 = v1 * sc; u32x4 w; w.x = cvt_pk_bf16(v0[0], v0[1]); w.y = cvt_pk_bf16(v0[2], v0[3]); w.z = cvt_pk_bf16(v1[0], v1[1]); w.w = cvt_pk_bf16(v1[2], v1[3]);
                    *(u32x4*)(rowp + bj * HALF) = w; } }
    }
};

struct PanelStats {
    unsigned* xbuf;
    unsigned* cnt;
    unsigned* tmo;
    int ntn; float eps;
    unsigned code;
    __device__ __forceinline__ bool run(const f32x4 (&v)[2][2][4][2], const Unit& u, int wr, int wc, int fr, int fq, PG8_LAS unsigned char* lds, int wid, int lane) const {
        typedef float f32x2v __attribute__((ext_vector_type(2)));
        PG8_LAS f32x2v* P = (PG8_LAS f32x2v*)lds;
        PG8_LAS f32x2v* S = (PG8_LAS f32x2v*)(lds + 8192);
        PG8_LAS unsigned* flag = (PG8_LAS unsigned*)(lds + 8192 + 2048);
#pragma unroll
        for (int ai = 0; ai < 2; ++ai)
#pragma unroll
            for (int m = 0; m < 4; ++m) {
                float s = 0.f;
#pragma unroll
                for (int bj = 0; bj < 2; ++bj)
#pragma unroll
                    for (int n = 0; n < 2; ++n) { const f32x4 x = v[ai][bj][m][n]; s += (x[0] + x[1]) + (x[2] + x[3]); }
                s += __shfl_xor(s, 16); s += __shfl_xor(s, 32);
                const float mw = s * (1.0f / 64.0f); float q = 0.f;
#pragma unroll
                for (int bj = 0; bj < 2; ++bj)
#pragma unroll
                    for (int n = 0; n < 2; ++n) { const f32x4 d = v[ai][bj][m][n] - mw; q += (d[0] * d[0] + d[1] * d[1]) + (d[2] * d[2] + d[3] * d[3]); }
                q += __shfl_xor(q, 16); q += __shfl_xor(q, 32);
                if (fq == 0) P[(ai * HALF + wr * 64 + m * 16 + fr) * 4 + wc] = (f32x2v){mw, q};
            }
        asm volatile("s_waitcnt lgkmcnt(0)" ::: "memory"); __builtin_amdgcn_s_barrier(); asm volatile("" ::: "memory");
#if defined(BROKEN_EXCHANGE_NO_WAIT)
#warning BROKEN CONTROL BUILD: the row-statistics exchange does not wait; results are wrong by design
        if (blockIdx.x >= 64) { const long long t0_ = clock64(); while (clock64() - t0_ < 60000) __builtin_amdgcn_s_sleep(8); }
#endif
        const int row = wid * 32 + (lane & 31);
        if (lane < 32) {
            const f32x2v a = P[row * 4 + 0], b = P[row * 4 + 1], c = P[row * 4 + 2], d = P[row * 4 + 3];
            const float mt = (a.x + b.x + c.x + d.x) * 0.25f;
            const float da = a.x - mt, db = b.x - mt, dc = c.x - mt, dd = d.x - mt;
            const float m2 = (a.y + b.y) + (c.y + d.y) + 64.0f * ((da * da + db * db) + (dc * dc + dd * dd));
            unsigned long long* slot = (unsigned long long*)xbuf + ((size_t)(u.pm * BM + row) * 4 + u.pn);
            __hip_atomic_store(slot, ((unsigned long long)__float_as_uint(m2) << 32) | __float_as_uint(mt), __ATOMIC_RELAXED, __HIP_MEMORY_SCOPE_AGENT);
        }
        asm volatile("s_waitcnt vmcnt(0)" ::: "memory");
        if (lane == 0) __hip_atomic_fetch_add(cnt + 64 * u.pm, 1u, __ATOMIC_RELAXED, __HIP_MEMORY_SCOPE_AGENT);
        if (wid == 0) {
            bool dead = false; const unsigned long long t0 = __builtin_amdgcn_s_memrealtime(); const unsigned want = 8u * (unsigned)ntn;
            for (;;) {
#if defined(BROKEN_EXCHANGE_NO_WAIT)
                break;
#endif
                if ((unsigned)__builtin_amdgcn_readfirstlane(__hip_atomic_load(cnt + 64 * u.pm, __ATOMIC_RELAXED, __HIP_MEMORY_SCOPE_AGENT)) >= want) break;
                if (__builtin_amdgcn_s_memrealtime() - t0 > 2000000ull) {
                    if (lane == 0) { unsigned expect = 0u; __hip_atomic_compare_exchange_strong(tmo + 1, &expect, code | (unsigned)(u.pm & 0xff), __ATOMIC_RELAXED, __ATOMIC_RELAXED, __HIP_MEMORY_SCOPE_AGENT);
                                     __hip_atomic_store(tmo, 1u, __ATOMIC_RELAXED, __HIP_MEMORY_SCOPE_AGENT); }
                    dead = true; break; }
                __builtin_amdgcn_s_sleep(2);
            }
            __builtin_amdgcn_fence(__ATOMIC_ACQUIRE, "agent");
            if (lane == 0) flag[0] = dead ? 1u : 0u;
        }
        asm volatile("s_waitcnt vmcnt(0) lgkmcnt(0)" ::: "memory"); __builtin_amdgcn_s_barrier(); asm volatile("" ::: "memory");
        const bool bad = flag[0] != 0u;
        if (lane < 32) {
            const unsigned long long* slot = (const unsigned long long*)xbuf + (size_t)(u.pm * BM + row) * 4; float mt[4], m2[4]; float ms = 0.f;
#pragma unroll
            for (int t = 0; t < 4; ++t) { if (t < ntn) { const unsigned long long w = __hip_atomic_load(slot + t, __ATOMIC_RELAXED, __HIP_MEMORY_SCOPE_AGENT); mt[t] = __uint_as_float((unsigned)w); m2[t] = __uint_as_float((unsigned)(w >> 32)); } else { mt[t] = 0.f; m2[t] = 0.f; } ms += mt[t]; }
            const float mean = ms / (float)ntn; float q = 0.f;
#pragma unroll
            for (int t = 0; t < 4; ++t) if (t < ntn) { const float dm = mt[t] - mean; q += m2[t] + 256.0f * dm * dm; }
            S[row] = (f32x2v){mean, 1.0f / sqrtf(q / (256.0f * (float)ntn) + eps)};
        }
        asm volatile("s_waitcnt lgkmcnt(0)" ::: "memory"); __builtin_amdgcn_s_barrier(); asm volatile("" ::: "memory");
        return bad;
    }
};
struct EpiLnRes {
    static constexpr bool PERM = false, AFTER_DRAIN = true;
    const float* base; float* out; int ldc; const float* bias; PanelStats st; unsigned poison;
    __device__ __forceinline__ void fused(f32x4 (&acc)[2][2][4][2], const Unit& u, int wr, int wc, int fr, int fq, PG8_LAS unsigned char* lds, int wid, int lane) const {
        typedef float f32x2v __attribute__((ext_vector_type(2)));
        const PG8_LAS f32x2v* S = (const PG8_LAS f32x2v*)(lds + 8192);
        const int col0 = u.pn * BM + wc * 32 + 4 * fq;
#pragma unroll
        for (int bj = 0; bj < 2; ++bj)
#pragma unroll
            for (int n = 0; n < 2; ++n) { const f32x4 bv = bias ? *(const f32x4*)(bias + col0 + bj * HALF + n * 16) : (f32x4){0.f, 0.f, 0.f, 0.f};
#pragma unroll
                for (int ai = 0; ai < 2; ++ai)
#pragma unroll
                    for (int m = 0; m < 4; ++m) acc[ai][bj][m][n] += bv; }
        f32x4 pre[4][2][2];
#pragma unroll
        for (int m = 0; m < 4; ++m) { const size_t off = (size_t)(u.pm * BM + wr * 64 + m * 16 + fr) * ldc + col0;
#pragma unroll
            for (int bj = 0; bj < 2; ++bj)
#pragma unroll
                for (int n = 0; n < 2; ++n) pre[m][bj][n] = *(const f32x4*)(base + off + bj * HALF + n * 16); }
        const bool bad = st.run(acc, u, wr, wc, fr, fq, lds, wid, lane) || poison != 0u;
        const float qnan = __builtin_nanf("");
#pragma unroll
        for (int ai = 0; ai < 2; ++ai)
#pragma unroll
            for (int m = 0; m < 4; ++m) { const int r = ai * HALF + wr * 64 + m * 16 + fr; const f32x2v sr = S[r]; const size_t off = (size_t)(u.pm * BM + r) * ldc + col0;
#pragma unroll
                for (int bj = 0; bj < 2; ++bj)
#pragma unroll
                    for (int n = 0; n < 2; ++n) { const f32x4 bs = ai == 0 ? pre[m][bj][n] : *(const f32x4*)(base + off + bj * HALF + n * 16); f32x4 o = bs + (acc[ai][bj][m][n] - sr.x) * sr.y;
                        if (bad) o = (f32x4){qnan, qnan, qnan, qnan}; *(f32x4*)(out + off + bj * HALF + n * 16) = o; }
                if (m & 1) asm volatile("" ::: "memory"); }
    }
};
struct EpiLnResLn {
    static constexpr bool PERM = false, AFTER_DRAIN = true;
    const float* base; float* out; bf16_t* xn; int ldc; const float* bias; PanelStats st1, st2; unsigned poison;
    __device__ __forceinline__ void fused(f32x4 (&acc)[2][2][4][2], const Unit& u, int wr, int wc, int fr, int fq, PG8_LAS unsigned char* lds, int wid, int lane) const {
        typedef float f32x2v __attribute__((ext_vector_type(2))); typedef unsigned u32x2v __attribute__((ext_vector_type(2)));
        const PG8_LAS f32x2v* S = (const PG8_LAS f32x2v*)(lds + 8192);
        const int col0 = u.pn * BM + wc * 32 + 4 * fq;
#pragma unroll
        for (int bj = 0; bj < 2; ++bj)
#pragma unroll
            for (int n = 0; n < 2; ++n) { const f32x4 bv = bias ? *(const f32x4*)(bias + col0 + bj * HALF + n * 16) : (f32x4){0.f, 0.f, 0.f, 0.f};
#pragma unroll
                for (int ai = 0; ai < 2; ++ai)
#pragma unroll
                    for (int m = 0; m < 4; ++m) acc[ai][bj][m][n] += bv; }
        bool bad = st1.run(acc, u, wr, wc, fr, fq, lds, wid, lane) || poison != 0u;
        const float qnan = __builtin_nanf("");
#pragma unroll
        for (int ai = 0; ai < 2; ++ai)
#pragma unroll
            for (int m = 0; m < 4; ++m) { const int r = ai * HALF + wr * 64 + m * 16 + fr; const f32x2v sr = S[r]; const size_t off = (size_t)(u.pm * BM + r) * ldc + col0;
#pragma unroll
                for (int bj = 0; bj < 2; ++bj)
#pragma unroll
                    for (int n = 0; n < 2; ++n) { const f32x4 bs = *(const f32x4*)(base + off + bj * HALF + n * 16); acc[ai][bj][m][n] = bs + (acc[ai][bj][m][n] - sr.x) * sr.y; }
                asm volatile("" : "+v"(acc[ai][0][m][0]), "+v"(acc[ai][0][m][1]), "+v"(acc[ai][1][m][0]), "+v"(acc[ai][1][m][1]));
                if (m & 1) asm volatile("" ::: "memory"); }
        const bool bad1 = bad;
        bad = st2.run(acc, u, wr, wc, fr, fq, lds, wid, lane) || bad;
#pragma unroll
        for (int ai = 0; ai < 2; ++ai)
#pragma unroll
            for (int m = 0; m < 4; ++m) { const int r = ai * HALF + wr * 64 + m * 16 + fr; const f32x2v sr = S[r]; const size_t off = (size_t)(u.pm * BM + r) * ldc + col0;
#pragma unroll
                for (int bj = 0; bj < 2; ++bj)
#pragma unroll
                    for (int n = 0; n < 2; ++n) { const f32x4 x1 = acc[ai][bj][m][n]; *(f32x4*)(out + off + bj * HALF + n * 16) = bad1 ? (f32x4){qnan, qnan, qnan, qnan} : x1;
                        const f32x4 o = (x1 - sr.x) * sr.y; u32x2v w; w.x = cvt_pk_bf16(o[0], o[1]); w.y = cvt_pk_bf16(o[2], o[3]);
                        if (bad) { w.x = 0x7fc07fc0u; w.y = 0x7fc07fc0u; } *(u32x2v*)(xn + off + bj * HALF + n * 16) = w; }
                asm volatile("" ::: "memory"); }
    }
};

template <class Epi, class Sched, bool ALIGN_EPI = false, bool SP2 = false>
__device__ __forceinline__ void gemm_phase(PG8_LAS unsigned char* lds, const Gemm g, const Sched& S, const Epi& E) {
    const int tid = threadIdx.x, wid = __builtin_amdgcn_readfirstlane(tid >> 6), lane = tid & 63, wr = wid >> 2, wc = wid & 3, fr = lane & 15, fq = lane >> 4;
    const int K = g.K, nt = K / BK;
    unsigned voffA[2], voffB[2];
#pragma unroll
    for (int i = 0; i < 2; ++i) { int R, C; stage_rc(tid * 16 + i * 8192, R, C); const int Rb = Epi::PERM ? ((R & ~31) + perm32(R & 31)) : R;
        voffA[i] = (unsigned)(R * K + C) * 2u; voffB[i] = (unsigned)(Rb * K + C) * 2u; }
    const size_t kstep = (size_t)(BK * 2);
    const size_t hstep = (size_t)HALF * K * 2;
    const size_t tstep = 2 * hstep;
    const unsigned ldsw = (unsigned)wid * 1024u;
    const int aoff = lds_byte(wr * 64 + fr, fq * 8), boff = lds_byte(wc * 32 + fr, fq * 8);
#define PG8_SA(b, h) (((b) * 2 + (h)) * HTB)
#define PG8_SB(b, h) ((4 + (b) * 2 + (h)) * HTB)
#define PG8_STAGE(bufoff, gbase, voff) do { _Pragma("unroll") for (int _i = 0; _i < 2; ++_i) \
        __builtin_amdgcn_global_load_lds((const unsigned*)((const char*)(gbase) + (voff)[_i]), (PG8_LAS unsigned*)(lds + (bufoff) + ldsw + _i * 8192), 16, 0, 0); } while (0)
#define PG8_LDA(dst, b, h) do { _Pragma("unroll") for (int m = 0; m < 4; ++m) _Pragma("unroll") for (int k = 0; k < 2; ++k) dst[m][k] = *(const PG8_LAS bf16x8*)(lds + PG8_SA(b, h) + aoff + m * 2048 + k * 1024); } while (0)
#define PG8_LDB(dst, b, h) do { _Pragma("unroll") for (int n = 0; n < 2; ++n) _Pragma("unroll") for (int k = 0; k < 2; ++k) dst[n][k] = *(const PG8_LAS bf16x8*)(lds + PG8_SB(b, h) + boff + n * 2048 + k * 1024); } while (0)
#define PG8_MMA(ai, bj, At, Bt) do { __builtin_amdgcn_s_setprio(1); _Pragma("unroll") for (int m = 0; m < 4; ++m) _Pragma("unroll") for (int n = 0; n < 2; ++n) _Pragma("unroll") for (int k = 0; k < 2; ++k) \
        acc[ai][bj][m][n] = __builtin_amdgcn_mfma_f32_16x16x32_bf16(Bt[n][k], At[m][k], acc[ai][bj][m][n], 0, 0, 0); __builtin_amdgcn_s_setprio(0); } while (0)
#define PG8_WAIT_V(n) asm volatile("s_waitcnt vmcnt(" #n ")" ::: "memory")
#define PG8_WAIT_L(n) asm volatile("s_waitcnt lgkmcnt(" #n ")" ::: "memory")
#define PG8_BAR __builtin_amdgcn_s_barrier()
#define PG8_SCHED __builtin_amdgcn_sched_barrier(0)
    Unit cur, nxt; int ui = 0;
    if (!S.next(0, cur)) return;
    f32x4 acc[2][2][4][2];
#pragma unroll
    for (int a = 0; a < 2; ++a)
#pragma unroll
        for (int b = 0; b < 2; ++b)
#pragma unroll
            for (int m = 0; m < 4; ++m)
#pragma unroll
                for (int n = 0; n < 2; ++n) acc[a][b][m][n] = (f32x4){0.f, 0.f, 0.f, 0.f};
    bf16x8 At[4][2], B0[2][2], B1[2][2];
    const char* cA = (const char*)g.A + (size_t)cur.pm * tstep; const char* cB = (const char*)g.Bt + (size_t)cur.pn * tstep;
    S.a_ready(cur);
    if constexpr (SP2) {
        PG8_STAGE(PG8_SB(0, 0), cB, voffB); PG8_STAGE(PG8_SB(0, 1), cB + hstep, voffB); PG8_STAGE(PG8_SA(0, 0), cA, voffA); PG8_STAGE(PG8_SA(0, 1), cA + hstep, voffA);
        if (wr == 1) PG8_BAR;
        PG8_WAIT_V(2); PG8_BAR;
        PG8_STAGE(PG8_SB(1, 0), cB + kstep, voffB); PG8_STAGE(PG8_SA(1, 0), cA + kstep, voffA); PG8_STAGE(PG8_SB(1, 1), cB + hstep + kstep, voffB);
        PG8_WAIT_V(6); PG8_BAR;
    } else {
        PG8_STAGE(PG8_SB(0, 0), cB, voffB); PG8_STAGE(PG8_SA(0, 0), cA, voffA); PG8_STAGE(PG8_SB(0, 1), cB + hstep, voffB); PG8_STAGE(PG8_SA(0, 1), cA + hstep, voffA);
        if (wr == 1) PG8_BAR;
        PG8_WAIT_V(4); PG8_BAR;
        PG8_STAGE(PG8_SB(1, 0), cB + kstep, voffB); PG8_STAGE(PG8_SA(1, 0), cA + kstep, voffA); PG8_STAGE(PG8_SB(1, 1), cB + hstep + kstep, voffB);
        PG8_WAIT_V(6); PG8_BAR;
    }
    for (;;) {
        const bool has_next = S.next(ui + 1, nxt);
        const char* nA = has_next ? (const char*)g.A + (size_t)nxt.pm * tstep : cA; const char* nB = has_next ? (const char*)g.Bt + (size_t)nxt.pn * tstep : cB;
        for (int t = 0; t < nt; t += 2) {
            const bool last = (t == nt - 2);
            const char* a1 = cA + (size_t)(t + 1) * kstep;
            const char* a2 = last ? nA : cA + (size_t)(t + 2) * kstep; const char* b2 = last ? nB : cB + (size_t)(t + 2) * kstep;
            const char* a3 = a2 + kstep; const char* b3 = b2 + kstep;
            if (last && has_next) S.a_ready(nxt);
            if constexpr (SP2) {
            PG8_LDB(B0, 0, 0); PG8_LDB(B1, 0, 1); PG8_SCHED; PG8_LDA(At, 0, 0); PG8_STAGE(PG8_SA(1, 1), a1 + hstep, voffA);
            PG8_WAIT_V(8); PG8_WAIT_L(0); PG8_BAR; PG8_MMA(0, 0, At, B0); PG8_MMA(0, 1, At, B1); PG8_BAR; PG8_SCHED;
            PG8_LDA(At, 0, 1); PG8_STAGE(PG8_SB(0, 0), b2, voffB); PG8_STAGE(PG8_SB(0, 1), b2 + hstep, voffB); PG8_STAGE(PG8_SA(0, 0), a2, voffA);
            PG8_WAIT_V(8); PG8_WAIT_L(0); PG8_BAR; PG8_MMA(1, 0, At, B0); PG8_MMA(1, 1, At, B1); PG8_BAR; PG8_SCHED;
            PG8_LDB(B0, 1, 0); PG8_LDB(B1, 1, 1); PG8_SCHED; PG8_LDA(At, 1, 0); PG8_STAGE(PG8_SA(0, 1), a2 + hstep, voffA);
            PG8_WAIT_V(8); PG8_WAIT_L(0); PG8_BAR; PG8_MMA(0, 0, At, B0); PG8_MMA(0, 1, At, B1); PG8_BAR; PG8_SCHED;
            PG8_LDA(At, 1, 1); PG8_STAGE(PG8_SB(1, 0), b3, voffB); PG8_STAGE(PG8_SB(1, 1), b3 + hstep, voffB); PG8_STAGE(PG8_SA(1, 0), a3, voffA);
            PG8_WAIT_V(8); PG8_WAIT_L(0); PG8_BAR; PG8_MMA(1, 0, At, B0); PG8_MMA(1, 1, At, B1); PG8_BAR; PG8_SCHED;
            } else {
            PG8_LDB(B0, 0, 0); PG8_SCHED; PG8_LDA(At, 0, 0); PG8_STAGE(PG8_SA(1, 1), a1 + hstep, voffA);
            PG8_WAIT_L(8); PG8_BAR; PG8_WAIT_L(0); PG8_MMA(0, 0, At, B0); PG8_BAR; PG8_SCHED;
            PG8_LDB(B1, 0, 1); PG8_STAGE(PG8_SB(0, 0), b2, voffB);
            PG8_BAR; PG8_WAIT_L(0); PG8_MMA(0, 1, At, B1); PG8_BAR;
            PG8_LDA(At, 0, 1); PG8_STAGE(PG8_SA(0, 0), a2, voffA);
            PG8_BAR; PG8_WAIT_L(0); PG8_MMA(1, 0, At, B0); PG8_BAR; PG8_SCHED;
            PG8_STAGE(PG8_SB(0, 1), b2 + hstep, voffB);
            PG8_WAIT_V(6); PG8_BAR; PG8_MMA(1, 1, At, B1); PG8_BAR;
            PG8_LDB(B0, 1, 0); PG8_SCHED; PG8_LDA(At, 1, 0); PG8_STAGE(PG8_SA(0, 1), a2 + hstep, voffA);
            PG8_WAIT_L(8); PG8_BAR; PG8_WAIT_L(0); PG8_MMA(0, 0, At, B0); PG8_BAR; PG8_SCHED;
            PG8_LDB(B1, 1, 1); PG8_STAGE(PG8_SB(1, 0), b3, voffB);
            PG8_BAR; PG8_WAIT_L(0); PG8_MMA(0, 1, At, B1); PG8_BAR;
            PG8_LDA(At, 1, 1); PG8_STAGE(PG8_SA(1, 0), a3, voffA);
            PG8_BAR; PG8_WAIT_L(0); PG8_MMA(1, 0, At, B0); PG8_BAR; PG8_SCHED;
            PG8_STAGE(PG8_SB(1, 1), b3 + hstep, voffB);
            PG8_WAIT_V(6); PG8_BAR; PG8_MMA(1, 1, At, B1); PG8_BAR;
            }
        }
        if constexpr (ALIGN_EPI) { if (wr == 0) PG8_BAR; }
        if constexpr (!Epi::AFTER_DRAIN) { E(acc, cur, wr, wc, fr, fq); S.done(cur); }
        if (!has_next) break;
#pragma unroll
        for (int a = 0; a < 2; ++a)
#pragma unroll
            for (int b = 0; b < 2; ++b)
#pragma unroll
                for (int m = 0; m < 4; ++m)
#pragma unroll
                    for (int n = 0; n < 2; ++n) acc[a][b][m][n] = (f32x4){0.f, 0.f, 0.f, 0.f};
        cur = nxt; cA = nA; cB = nB; ++ui;
        if constexpr (ALIGN_EPI) { if (wr == 1) PG8_BAR; }
    }
    PG8_WAIT_V(0);
    if constexpr (!ALIGN_EPI) { if (wr == 0) PG8_BAR; }
    PG8_BAR;
    if constexpr (Epi::AFTER_DRAIN) { E.fused(acc, cur, wr, wc, fr, fq, lds, wid, lane); S.done(cur); }
#undef PG8_SA
#undef PG8_SB
#undef PG8_STAGE
#undef PG8_LDA
#undef PG8_LDB
#undef PG8_MMA
#undef PG8_WAIT_V
#undef PG8_WAIT_L
#undef PG8_BAR
#undef PG8_SCHED
}
}
namespace pg8 {
struct EpiF32 {
    static constexpr bool PERM = false, AFTER_DRAIN = false;
    float* C; int ldc;
    __device__ __forceinline__ void operator()(const f32x4 (&acc)[2][2][4][2], const Unit& u, int wr, int wc, int fr, int fq) const {
        const int row0 = u.pm * BM + wr * 64 + fr, col0 = u.pn * BM + wc * 32 + 4 * fq;
#pragma unroll
        for (int ai = 0; ai < 2; ++ai)
#pragma unroll
            for (int m = 0; m < 4; ++m) { float* rowp = C + (size_t)(row0 + ai * HALF + m * 16) * ldc + col0;
#pragma unroll
                for (int bj = 0; bj < 2; ++bj)
#pragma unroll
                    for (int n = 0; n < 2; ++n) *(f32x4*)(rowp + bj * HALF + n * 16) = acc[ai][bj][m][n]; }
    }
};
struct EpiB16 {
    static constexpr bool PERM = true, AFTER_DRAIN = false;
    bf16_t* O; int ldc;
    __device__ __forceinline__ void operator()(const f32x4 (&acc)[2][2][4][2], const Unit& u, int wr, int wc, int fr, int fq) const {
        const int row0 = u.pm * BM + wr * 64 + fr, col0 = u.pn * BM + wc * 32 + 8 * fq;
#pragma unroll
        for (int ai = 0; ai < 2; ++ai)
#pragma unroll
            for (int m = 0; m < 4; ++m) { bf16_t* rowp = O + (size_t)(row0 + ai * HALF + m * 16) * ldc + col0;
#pragma unroll
                for (int bj = 0; bj < 2; ++bj) { const f32x4 v0 = acc[ai][bj][m][0], v1 = acc[ai][bj][m][1];
                    u32x4 w; w.x = cvt_pk_bf16(v0[0], v0[1]); w.y = cvt_pk_bf16(v0[2], v0[3]); w.z = cvt_pk_bf16(v1[0], v1[1]); w.w = cvt_pk_bf16(v1[2], v1[3]);
                    *(u32x4*)(rowp + bj * HALF) = w; } }
    }
};
__device__ __forceinline__ float silu_f(float g) { return g * __builtin_amdgcn_rcpf(1.0f + __builtin_amdgcn_exp2f(-1.4426950408889634f * g)); }
struct EpiSwiGLU {
    static constexpr bool PERM = true, AFTER_DRAIN = false;
    bf16_t* H; int ldh;
    __device__ __forceinline__ void operator()(const f32x4 (&acc)[2][2][4][2], const Unit& u, int wr, int wc, int fr, int fq) const {
        const int row0 = u.pm * BM + wr * 64 + fr, col0 = u.pn * HALF + wc * 32 + 8 * fq;
#pragma unroll
        for (int ai = 0; ai < 2; ++ai)
#pragma unroll
            for (int m = 0; m < 4; ++m) { bf16_t* rowp = H + (size_t)(row0 + ai * HALF + m * 16) * ldh + col0;
                const f32x4 g0 = acc[ai][0][m][0], g1 = acc[ai][0][m][1], u0 = acc[ai][1][m][0], u1 = acc[ai][1][m][1];
                u32x4 w; w.x = cvt_pk_bf16(silu_f(g0[0]) * u0[0], silu_f(g0[1]) * u0[1]); w.y = cvt_pk_bf16(silu_f(g0[2]) * u0[2], silu_f(g0[3]) * u0[3]);
                w.z = cvt_pk_bf16(silu_f(g1[0]) * u1[0], silu_f(g1[1]) * u1[1]); w.w = cvt_pk_bf16(silu_f(g1[2]) * u1[2], silu_f(g1[3]) * u1[3]);
                *(u32x4*)rowp = w; }
    }
};
}

constexpr int NWAVES = 8, NTHREADS = 512;
constexpr int BATCH = 8, SEQ = 2048, DM = 1024, MTOK = BATCH * SEQ, DFF = 2816;
constexpr int AW = 512, AH = 8, AHD = 64, WLORA = 64, ALORA = 64, GLORA = 128, APROJ = 3 * AW + WLORA + ALORA + GLORA  ;
constexpr int BW = 512, BBLK = 8, BBD = 64, INPROJ = APROJ + 2 * BW  ;
constexpr int CH = 16, CHD = 64;
constexpr float NORM_EPS = 1e-6f, GN_EPS = 64e-5f;
constexpr int TCH = 128, NCHUNK = SEQ / TCH;

constexpr size_t MiB = 1u << 20;
constexpr size_t WS_CTL = 0;
constexpr int W_L0F1_1 = 2, W_L0F1_2 = 13, W_L0_IN = 19, W_L0_OUT = 25, W_L0F2_1 = 27, W_L0F2_2 = 38, W_L1F1_1 = 44, W_L1F1_2 = 55, W_L1_QKV = 61, W_L1_OUT = 67, W_L1F2_1 = 69, W_L1F2_2 = 80;
constexpr int R_BIG = 86, R_XN = 182, R_FREE = 214, R_END = 256;
constexpr int F_SCANIN = 0  , F_LRUIN = 12  , F_YRAW = 16  , F_LRUH = 18  , F_G = 20  , F_BONUS = 22  , F_STATE = 23  , F_LSTATE = 24;
constexpr size_t CTL_ZERO_BYTES = 1 * MiB;

typedef unsigned short bf16;
typedef float f32x4 __attribute__((ext_vector_type(4)));
typedef unsigned u32x4v __attribute__((ext_vector_type(4)));
typedef unsigned u32x2v __attribute__((ext_vector_type(2)));
#define LAS __attribute__((address_space(3)))

__device__ __forceinline__ unsigned f2bf(float f) { unsigned u = __builtin_bit_cast(unsigned, f); return (u + 0x7fffu + ((u >> 16) & 1u)) >> 16; }
__device__ __forceinline__ unsigned pk2(float lo, float hi) { return f2bf(lo) | (f2bf(hi) << 16); }
__device__ __forceinline__ float bf2f(unsigned b) { return __builtin_bit_cast(float, b << 16); }
__device__ __forceinline__ float wave_sum(float v) {
#pragma unroll
    for (int o = 1; o < 64; o <<= 1) v += __shfl_xor(v, o);
    return v;
}
__device__ __forceinline__ float softplus_f(float x) { return fmaxf(x, 0.f) + log1pf(expf(-fabsf(x))); }
__device__ __forceinline__ float sigmoid_f(float x) { return 1.0f / (1.0f + expf(-x)); }
__device__ __forceinline__ float gelu_tanh_f(float x) { const float u = 0.7978845608028654f * (x + 0.044715f * x * x * x); return 0.5f * x * (1.0f + tanhf(u)); }

enum OpKind { OP_CONV = 0, OP_ROWS = 1, OP_GEMM = 2, OP_PREP = 3, OP_SCAN = 4, OP_POST = 5, OP_ATTN = 6 };
enum { RM_COPY = 1, RM_RES = 2, RM_NORM = 4 };
enum { EPI_F32 = 0, EPI_B16 = 1, EPI_SWIGLU = 2 };
struct Op { int kind; int a, b, c, d, e, f, g; };
constexpr int MAX_OPS = 96;
struct Args { const float* in[43]; float* out; unsigned char* ws; int op_lo, op_hi; Op ops[MAX_OPS]; };

constexpr int LDSCTL_OFF = 131072, MISC_OFF = LDSCTL_OFF + 320, INTAB_OFF = LDSCTL_OFF + 512;
struct InTab { LAS const unsigned long long* t; __device__ __forceinline__ const float* operator[](int k) const { return (const float*)t[k]; } };
struct Ctx {
    LAS unsigned char* lds;
    InTab in; float* xres; unsigned char* ws;
    int tid, lane, wave, G, bid;
};

__device__ __forceinline__ void conv_item(const float* W, int K, int N, bf16* WT, int mode, LAS float* scr, int item, int lane) {
    const int nblk = N / 32, kb = item / nblk, nb = item % nblk, k0 = 64 * kb, n0 = 32 * nb;
#pragma unroll 8
    for (int i = 0; i < 32; ++i) { const int kk = 2 * i + (lane >> 5); scr[kk * 33 + (lane & 31)] = W[(size_t)(k0 + kk) * N + n0 + (lane & 31)]; }
    asm volatile("s_waitcnt lgkmcnt(0)" ::: "memory");
    int r0 = n0;
    if (mode == 1) { const int up = n0 >= DFF ? 1 : 0, j = n0 - up * DFF; r0 = (j >> 7) * 256 + up * 128 + (j & 127); }
    const int c = lane & 7;
#pragma unroll
    for (int j = 0; j < 4; ++j) { const int n = (lane >> 3) + 8 * j; const LAS float* s = scr + (8 * c) * 33 + n;
        u32x4v o; o.x = pk2(s[0 * 33], s[1 * 33]); o.y = pk2(s[2 * 33], s[3 * 33]); o.z = pk2(s[4 * 33], s[5 * 33]); o.w = pk2(s[6 * 33], s[7 * 33]);
        *(u32x4v*)(WT + (size_t)(r0 + n) * K + k0 + 8 * c) = o; }
    asm volatile("s_waitcnt lgkmcnt(0)" ::: "memory");
}
struct ConvDesc { int in_idx, K, N, dst, mode; };
__constant__ ConvDesc CONV_TAB[12] = { {3, DM, 2 * DFF, W_L0F1_1, 1}, {4, DFF, DM, W_L0F1_2, 0}, {7, DM, INPROJ, W_L0_IN, 0}, {26, DM, DM, W_L0_OUT, 0},
                             {29, DM, 2 * DFF, W_L0F2_1, 1}, {30, DFF, DM, W_L0F2_2, 0}, {33, DM, 2 * DFF, W_L1F1_1, 1}, {34, DFF, DM, W_L1F1_2, 0},
                             {37, DM, 3 * DM, W_L1_QKV, 0}, {38, DM, DM, W_L1_OUT, 0}, {41, DM, 2 * DFF, W_L1F2_1, 1}, {42, DFF, DM, W_L1F2_2, 0} };
__device__ __forceinline__ void op_conv(const Ctx& C) {
    const ConvDesc* D = CONV_TAB;
    LAS float* scr = (LAS float*)(C.lds + C.wave * 16384);
    const int gw = C.bid * NWAVES + C.wave, NGW = C.G * NWAVES;
    int base = 0;
#pragma unroll 1
    for (int d = 0; d < 12; ++d) {
        const int K = D[d].K, N = D[d].N, nit = (K / 64) * (N / 32);
        const float* W = C.in[D[d].in_idx]; bf16* WT = (bf16*)(C.ws + (size_t)D[d].dst * MiB);
        int it = ((gw - base) % NGW + NGW) % NGW;
#pragma unroll 1
        for (; it < nit; it += NGW) conv_item(W, K, N, WT, D[d].mode, scr, it, C.lane);
        base += nit;
    }
}

__device__ __forceinline__ void op_rows(const Ctx& C, const Op& op) {
    const int mode = op.a; const float coef = 0.5f * (float)op.c;
    const float* Y = (const float*)(C.ws + (size_t)op.b * MiB);
    const float* gpost = C.in[op.d]; const float* gpre = C.in[op.e];
    bf16* XN = (bf16*)(C.ws + (size_t)R_XN * MiB);
    const float* xsrc = (mode & RM_COPY) ? C.in[0] : C.xres;
    const int gw = C.bid * NWAVES + C.wave, NGW = C.G * NWAVES;
#pragma unroll 1
    for (int m = gw; m < MTOK; m += NGW) {
        const f32x4* xr = (const f32x4*)(xsrc + (size_t)m * DM) + C.lane;
        f32x4 v[4];
#pragma unroll
        for (int j = 0; j < 4; ++j) v[j] = xr[64 * j];
        if (mode & RM_RES) {
            const f32x4* yr = (const f32x4*)(Y + (size_t)m * DM) + C.lane; f32x4 y[4]; float s = 0.f;
#pragma unroll
            for (int j = 0; j < 4; ++j) { y[j] = yr[64 * j]; s += (y[j].x * y[j].x + y[j].y * y[j].y) + (y[j].z * y[j].z + y[j].w * y[j].w); }
            const float rstd = coef / sqrtf(wave_sum(s) * (1.f / DM) + NORM_EPS);
#pragma unroll
            for (int j = 0; j < 4; ++j) { const f32x4 g = ((const f32x4*)gpost)[C.lane + 64 * j]; v[j] = v[j] + y[j] * g * rstd; }
        }
        if (mode & (RM_RES | RM_COPY)) { f32x4* xo = (f32x4*)(C.xres + (size_t)m * DM) + C.lane;
#pragma unroll
            for (int j = 0; j < 4; ++j) xo[64 * j] = v[j]; }
        if (mode & RM_NORM) {
            float s = 0.f;
#pragma unroll
            for (int j = 0; j < 4; ++j) s += (v[j].x * v[j].x + v[j].y * v[j].y) + (v[j].z * v[j].z + v[j].w * v[j].w);
            const float rstd = 1.0f / sqrtf(wave_sum(s) * (1.f / DM) + NORM_EPS);
            u32x2v* o8 = (u32x2v*)(XN + (size_t)m * DM) + C.lane;
#pragma unroll
            for (int j = 0; j < 4; ++j) { const f32x4 g = ((const f32x4*)gpre)[C.lane + 64 * j]; const f32x4 o = v[j] * g * rstd; u32x2v w; w.x = pk2(o.x, o.y); w.y = pk2(o.z, o.w); o8[64 * j] = w; }
        }
    }
}

__device__ __forceinline__ void op_gemm(const Ctx& C, const Op& op) {
    pg8::Gemm g{(const pg8::bf16_t*)(C.ws + (size_t)op.a * MiB), (const pg8::bf16_t*)(C.ws + (size_t)op.b * MiB), MTOK, op.c, op.d};
    pg8::StaticOrder S; S.init(MTOK, op.c, C.G, C.bid);
    void* dst = (void*)(C.ws + (size_t)op.f * MiB);
    if (op.e == EPI_F32) { pg8::EpiF32 E{(float*)dst, op.g}; pg8::gemm_phase<pg8::EpiF32, pg8::StaticOrder, true, true>(C.lds, g, S, E); }
    else if (op.e == EPI_B16) { pg8::EpiB16 E{(pg8::bf16_t*)dst, op.g}; pg8::gemm_phase<pg8::EpiB16, pg8::StaticOrder, true, true>(C.lds, g, S, E); }
    else { pg8::EpiSwiGLU E{(pg8::bf16_t*)dst, op.g}; pg8::gemm_phase<pg8::EpiSwiGLU, pg8::StaticOrder, true, true>(C.lds, g, S, E); }
}

__device__ __forceinline__ void op_prep(const Ctx& C, const Op& op) {
    const int chunk = op.a, j = C.tid;
    const bf16* proj = (const bf16*)(C.ws + (size_t)R_BIG * MiB);
    unsigned char* fr = C.ws + (size_t)R_FREE * MiB;
    float* scanin = (float*)(fr + (size_t)F_SCANIN * MiB); float* lruin = (float*)(fr + (size_t)F_LRUIN * MiB);
    float* gbuf = (float*)(fr + (size_t)F_G * MiB); float* bonus = (float*)(fr + (size_t)F_BONUS * MiB);
    const float* mu = C.in[8]; const float* w0 = C.in[9]; const float* w2 = C.in[10]; const float* a0 = C.in[11]; const float* a2 = C.in[12]; const float* g2 = C.in[13];
    const float* k_k = C.in[14]; const float* k_a = C.in[15]; const float* r_k = C.in[16];
    const float* conv_w = C.in[19]; const float* conv_b = C.in[20]; const float* gaw = C.in[21]; const float* gab = C.in[22]; const float* gxw = C.in[23]; const float* gxb = C.in[24]; const float* lam = C.in[25];
    LAS float* rows = (LAS float*)C.lds;
    LAS float* lin = rows + 7 * INPROJ;
    LAS float* xcs = lin + 4 * 256;
#pragma unroll 1
    for (int grp = C.bid; grp < (BATCH * TCH) / 4; grp += C.G) {
        const int i0 = grp * 4, b = i0 / TCH, tt0 = i0 % TCH, t0 = chunk * TCH + tt0;
        __syncthreads();
        for (int e = C.tid; e < 7 * INPROJ; e += NTHREADS) { const int rr = e / INPROJ, col = e % INPROJ, t = t0 - 3 + rr;
            rows[e] = (t >= 0) ? bf2f(proj[((size_t)(b * SEQ + t)) * INPROJ + col]) : 0.f; }
        __syncthreads();
        for (int e = C.tid; e < 4 * 256; e += NTHREADS) { const int tk = e >> 8, i = e & 255, col = 3 * AW + i;
            const float cur = rows[(3 + tk) * INPROJ + col], prv = rows[(2 + tk) * INPROJ + col]; const float s = cur + mu[col] * (prv - cur);
            lin[e] = (i < 64) ? tanhf(s) : (i < 128 ? s : sigmoid_f(s)); }
#pragma unroll
        for (int tk = 0; tk < 4; ++tk) { float a = conv_b[j];
#pragma unroll
            for (int i = 0; i < 4; ++i) a += rows[(tk + i) * INPROJ + APROJ + j] * conv_w[i * BW + j];
            xcs[tk * 512 + j] = a; }
        __syncthreads();
        float wp[4], ap[4], gg[4], ra[4], ix[4];
#pragma unroll
        for (int tk = 0; tk < 4; ++tk) { wp[tk] = w0[j]; ap[tk] = a0[j]; gg[tk] = 0.f; ra[tk] = gab[j]; ix[tk] = gxb[j]; }
#pragma unroll 4
        for (int i = 0; i < 64; ++i) { const float ww = w2[i * AW + j], aa = a2[i * AW + j];
#pragma unroll
            for (int tk = 0; tk < 4; ++tk) { wp[tk] += lin[tk * 256 + i] * ww; ap[tk] += lin[tk * 256 + 64 + i] * aa; } }
#pragma unroll 4
        for (int i = 0; i < 128; ++i) { const float gw_ = g2[i * AW + j];
#pragma unroll
            for (int tk = 0; tk < 4; ++tk) gg[tk] += lin[tk * 256 + 128 + i] * gw_; }
        { const int n = j >> 6, jj = j & 63;
#pragma unroll 4
          for (int i = 0; i < 64; ++i) { const float wa = gaw[(n * 64 + i) * 64 + jj], wx = gxw[(n * 64 + i) * 64 + jj];
#pragma unroll
            for (int tk = 0; tk < 4; ++tk) { const float xv = xcs[tk * 512 + n * 64 + i]; ra[tk] += xv * wa; ix[tk] += xv * wx; } } }
        const int h = j >> 6, jj = j & 63;
#pragma unroll
        for (int tk = 0; tk < 4; ++tk) {
            const int tt = tt0 + tk;
            const LAS float* cur = rows + (3 + tk) * INPROJ; const LAS float* prv = rows + (2 + tk) * INPROJ;
            const float r = cur[j] + mu[j] * (prv[j] - cur[j]);
            const float k = cur[AW + j] + mu[AW + j] * (prv[AW + j] - cur[AW + j]);
            const float v = cur[2 * AW + j] + mu[2 * AW + j] * (prv[2 * AW + j] - cur[2 * AW + j]);
            const float wlog = -softplus_f(-wp[tk]) - 0.5f; const float decay = expf(-expf(wlog));
            const float a = sigmoid_f(ap[tk]);
            const float kkr = k * k_k[j]; const float ss = wave_sum(kkr * kkr); const float kk = kkr / fmaxf(sqrtf(ss), 1e-12f);
            const float kh = k * (1.0f + (a - 1.0f) * k_a[j]);
            const float bo = wave_sum(r * kh * r_k[j]);
            float* si = scanin + ((size_t)((b * AH + h) * TCH + tt)) * 384;
            si[0 * 64 + jj] = kk; si[1 * 64 + jj] = decay; si[2 * 64 + jj] = kk * a; si[3 * 64 + jj] = kh; si[4 * 64 + jj] = r; si[5 * 64 + jj] = v;
            gbuf[((size_t)(b * TCH + tt)) * AW + j] = gg[tk];
            if (jj == 0) bonus[(b * TCH + tt) * AH + h] = bo;
            const float rg = sigmoid_f(ra[tk]), ig = sigmoid_f(ix[tk]);
            const float log_a = -8.0f * rg * softplus_f(-lam[j]);
            const float al = expf(log_a), mult = sqrtf(-expm1f(2.0f * log_a));
            float* li = lruin + ((size_t)(b * TCH + tt)) * 1024;
            li[j] = al; li[512 + j] = mult * ig * xcs[tk * 512 + j];
        }
    }
}

template <int CTRL> __device__ __forceinline__ float dppx(float v) { return __builtin_bit_cast(float, __builtin_amdgcn_update_dpp(0, __builtin_bit_cast(int, v), CTRL, 0xF, 0xF, true)); }
__device__ __forceinline__ float sum16(float v) { v += dppx<0xB1>(v); v += dppx<0x4E>(v); v += dppx<0x141>(v); v += dppx<0x140>(v); return v; }
constexpr int SUBT = 32, NSUB = TCH / SUBT, SUBF = SUBT * 384;
typedef __attribute__((address_space(1))) float gfloat;
typedef __attribute__((address_space(1))) f32x4 gf32x4;
struct ScanOps { f32x4 kk, w, kka, kh, r; float v; };
__device__ __forceinline__ void scan_load(ScanOps& o, const LAS float* p, int k0, int row) {
    o.kk = *(const LAS f32x4*)(p + k0); o.w = *(const LAS f32x4*)(p + 64 + k0); o.kka = *(const LAS f32x4*)(p + 128 + k0); o.kh = *(const LAS f32x4*)(p + 192 + k0); o.r = *(const LAS f32x4*)(p + 256 + k0); o.v = p[320 + row];
}
__device__ __forceinline__ float scan_step(f32x4& S, const ScanOps& o) {
    const float sa = -sum16((S.x * o.kk.x + S.y * o.kk.y) + (S.z * o.kk.z + S.w * o.kk.w));
    S = S * o.w + (o.kka * sa + o.kh * o.v);
    return sum16((S.x * o.r.x + S.y * o.r.y) + (S.z * o.r.z + S.w * o.r.w));
}
__device__ __forceinline__ void op_scan(const Ctx& C, const Op& op) {
    const int chunk = op.a;
    unsigned char* fr = C.ws + (size_t)R_FREE * MiB;
    const gfloat* scanin = (const gfloat*)(fr + (size_t)F_SCANIN * MiB); const gfloat* lruin = (const gfloat*)(fr + (size_t)F_LRUIN * MiB);
    gfloat* yraw = (gfloat*)(fr + (size_t)F_YRAW * MiB); gfloat* lruh = (gfloat*)(fr + (size_t)F_LRUH * MiB);
    gfloat* state = (gfloat*)(fr + (size_t)F_STATE * MiB); gfloat* lstate = (gfloat*)(fr + (size_t)F_LSTATE * MiB);
    LAS float* buf = (LAS float*)C.lds;
#pragma unroll 1
    for (int item = C.bid; item < BATCH * AH * 4; item += C.G) {
        const int bh = item >> 2, vg = item & 3, b = bh >> 3, h = bh & 7;
        const gfloat* si = scanin + (size_t)bh * TCH * 384;
        __syncthreads();
#pragma unroll
        for (int i = 0; i < 6; ++i) ((LAS f32x4*)buf)[i * 512 + C.tid] = ((const gf32x4*)si)[i * 512 + C.tid];
        __syncthreads();
        const int lrow = (C.wave & 3) * 4 + (C.lane >> 4), row = vg * 16 + lrow, k0 = 4 * (C.lane & 15), l15 = C.lane & 15;
        f32x4 S = (f32x4){0.f, 0.f, 0.f, 0.f};
        gfloat* sp = state + ((size_t)(bh * 64 + row)) * 64 + k0;
        const int c = h * 64 + C.lane;
        float hs = 0.f;
        if (chunk > 0) { if (C.wave < 4) S = *(const gf32x4*)sp; else if (C.wave == 4 && vg == 0) hs = lstate[b * BW + c]; }
#pragma unroll 1
        for (int sub = 0; sub < NSUB; ++sub) {
            const LAS float* cur = buf + (sub & 1) * SUBF;
            if (C.wave >= 4) {
                if (sub + 1 < NSUB) { LAS f32x4* dst = (LAS f32x4*)(buf + ((sub + 1) & 1) * SUBF); const gf32x4* src = (const gf32x4*)(si + (size_t)(sub + 1) * SUBF); const int ti = C.tid - 256;
#pragma unroll
                    for (int i = 0; i < 12; ++i) dst[i * 256 + ti] = src[i * 256 + ti]; }
                if (C.wave == 4 && vg == 0) {
                    const gfloat* li = lruin + ((size_t)(b * TCH + sub * SUBT)) * 1024 + c; gfloat* lo = lruh + ((size_t)(b * TCH + sub * SUBT)) * BW + c;
                    float av[SUBT], uv[SUBT];
#pragma unroll
                    for (int i = 0; i < SUBT; ++i) { av[i] = li[i * 1024]; uv[i] = li[i * 1024 + 512]; }
#pragma unroll
                    for (int i = 0; i < SUBT; ++i) { hs = av[i] * hs + uv[i]; lo[i * BW] = hs; }
                }
            } else {
                gfloat* yo = yraw + ((size_t)(b * TCH + sub * SUBT + l15)) * AW + h * 64 + row;
                ScanOps o0, o1;
                scan_load(o0, cur, k0, lrow + vg * 16);
#pragma unroll
                for (int half = 0; half < 2; ++half) {
                    float yv = 0.f;
#pragma unroll
                    for (int t2 = 0; t2 < 16; t2 += 2) {
                        const int tt = half * 16 + t2;
                        scan_load(o1, cur + (tt + 1) * 384, k0, lrow + vg * 16);
                        const float ya = scan_step(S, o0); yv = (l15 == t2) ? ya : yv;
                        if (tt + 2 < SUBT) scan_load(o0, cur + (tt + 2) * 384, k0, lrow + vg * 16);
                        const float yb = scan_step(S, o1); yv = (l15 == t2 + 1) ? yb : yv;
                    }
                    yo[(size_t)half * 16 * AW] = yv;
                }
            }
            __syncthreads();
        }
        if (C.wave < 4) *(gf32x4*)sp = S; else if (C.wave == 4 && vg == 0) lstate[b * BW + c] = hs;
    }
}

__device__ __forceinline__ void op_post(const Ctx& C, const Op& op) {
    const int chunk = op.a, j = C.tid, h = j >> 6, jj = j & 63;
    const bf16* proj = (const bf16*)(C.ws + (size_t)R_BIG * MiB);
    unsigned char* fr = C.ws + (size_t)R_FREE * MiB;
    const float* scanin = (const float*)(fr + (size_t)F_SCANIN * MiB);
    const float* yraw = (const float*)(fr + (size_t)F_YRAW * MiB); const float* lruh = (const float*)(fr + (size_t)F_LRUH * MiB);
    const float* gbuf = (const float*)(fr + (size_t)F_G * MiB); const float* bonus = (const float*)(fr + (size_t)F_BONUS * MiB);
    const float* lnx_g = C.in[17]; const float* lnx_b = C.in[18];
    bf16* AO = (bf16*)(C.ws + (size_t)R_XN * MiB);
#pragma unroll 1
    for (int i = C.bid; i < BATCH * TCH; i += C.G) {
        const int b = i / TCH, tt = i % TCH, t = chunk * TCH + tt; const size_t m = (size_t)b * SEQ + t;
        const float y = yraw[(size_t)i * AW + j];
        const float mean = wave_sum(y) * (1.f / 64.f); const float d = y - mean; const float var = wave_sum(d * d) * (1.f / 64.f);
        const float yn = d * (1.0f / sqrtf(var + GN_EPS)) * lnx_g[j] + lnx_b[j];
        const float v = scanin[((size_t)((b * AH + h) * TCH + tt)) * 384 + 320 + jj];
        const float ya = (yn + bonus[i * AH + h] * v) * gbuf[(size_t)i * AW + j];
        const float gb = bf2f(proj[m * INPROJ + APROJ + BW + j]);
        const float yb = lruh[(size_t)i * BW + j] * gelu_tanh_f(gb);
        AO[m * DM + j] = (bf16)f2bf(ya); AO[m * DM + AW + j] = (bf16)f2bf(yb);
    }
}

typedef short bf16x8v __attribute__((ext_vector_type(8)));
typedef float f32x16 __attribute__((ext_vector_type(16)));
typedef short s16x4v __attribute__((ext_vector_type(4)));
typedef __attribute__((address_space(1))) u32x4v gu32x4v;
typedef __attribute__((address_space(1))) u32x2v gu32x2v;
constexpr float AT_C2 = 0.125f * 1.4426950408889634f;
#ifndef AT_EARLY
#define AT_EARLY 1
#endif
constexpr float AT_THR = 144.0f;
typedef float f32x2_t __attribute__((ext_vector_type(2))); typedef __bf16 bf16x2_t __attribute__((ext_vector_type(2)));
__device__ __forceinline__ unsigned cvtpk(float lo, float hi) { f32x2_t v = {lo, hi}; bf16x2_t b = __builtin_convertvector(v, bf16x2_t); return __builtin_bit_cast(unsigned, b); }
__device__ __forceinline__ s16x4v vtr(const LAS unsigned char* p) { typedef short v4i16_t __attribute__((ext_vector_type(4))); return __builtin_bit_cast(s16x4v, __builtin_amdgcn_ds_read_tr16_b64_v4i16((LAS v4i16_t*)p)); }
__device__ __forceinline__ float softplus2(float z) { const float e = __builtin_amdgcn_exp2f(-__builtin_fabsf(z)); return __builtin_fmaxf(z, 0.f) + __builtin_amdgcn_logf(1.0f + e); }
__device__ __forceinline__ bf16x8v pack8(const f32x16& p, int s8) {
    u32x4v w; w.x = cvtpk(p[s8 + 0], p[s8 + 1]); w.y = cvtpk(p[s8 + 2], p[s8 + 3]); w.z = cvtpk(p[s8 + 4], p[s8 + 5]); w.w = cvtpk(p[s8 + 6], p[s8 + 7]); return __builtin_bit_cast(bf16x8v, w);
}
template <bool DIAG>
__device__ __forceinline__ void attn_tile(f32x16 (&o)[2], float& carry, const bf16x8v (&qf)[4], const bf16x8v (&tri)[2], const LAS unsigned char* Kt, const LAS unsigned char* Vt,
                                          const int (&koff)[4], const int (&voff)[2], int keybase  , int q, int lane) {
    f32x16 p0, p1;
#pragma unroll
    for (int d0 = 0; d0 < 4; ++d0) {
        const bf16x8v k0 = *(const LAS bf16x8v*)(Kt + koff[d0]), k1 = *(const LAS bf16x8v*)(Kt + 4096 + koff[d0]);
        if (d0 == 0) { const f32x16 zz = {}; p0 = __builtin_amdgcn_mfma_f32_32x32x16_bf16(k0, qf[0], zz, 0, 0, 0); p1 = __builtin_amdgcn_mfma_f32_32x32x16_bf16(k1, qf[0], zz, 0, 0, 0); }
        else { p0 = __builtin_amdgcn_mfma_f32_32x32x16_bf16(k0, qf[d0], p0, 0, 0, 0); p1 = __builtin_amdgcn_mfma_f32_32x32x16_bf16(k1, qf[d0], p1, 0, 0, 0); }
    }
    f32x16 s0, s1;
#pragma unroll
    for (int r = 0; r < 16; ++r) {
        float a = softplus2(p0[r]), c = softplus2(p1[r]);
        if (DIAG) { const int key = keybase + (r & 3) + 8 * (r >> 2); a = (key < q) ? a : 0.f; c = (key + 32 < q) ? c : 0.f; }
        s0[r] = a; s1[r] = c;
    }
    const bf16x8v f00 = pack8(s0, 0), f01 = pack8(s0, 8), f10 = pack8(s1, 0), f11 = pack8(s1, 8);
    const bf16x8v ones = {(short)0x3f80, (short)0x3f80, (short)0x3f80, (short)0x3f80, (short)0x3f80, (short)0x3f80, (short)0x3f80, (short)0x3f80};
    f32x16 cv;
#pragma unroll
    for (int r = 0; r < 16; ++r) cv[r] = carry;
    f32x16 c0 = __builtin_amdgcn_mfma_f32_32x32x16_bf16(tri[0], f00, cv, 0, 0, 0);
    c0 = __builtin_amdgcn_mfma_f32_32x32x16_bf16(tri[1], f01, c0, 0, 0, 0);
    c0 = __builtin_amdgcn_mfma_f32_32x32x16_bf16(ones, f10, c0, 0, 0, 0);
    c0 = __builtin_amdgcn_mfma_f32_32x32x16_bf16(ones, f11, c0, 0, 0, 0);
    f32x16 c1 = __builtin_amdgcn_mfma_f32_32x32x16_bf16(tri[0], f10, cv, 0, 0, 0);
    c1 = __builtin_amdgcn_mfma_f32_32x32x16_bf16(tri[1], f11, c1, 0, 0, 0);
#pragma unroll
    for (int r = 0; r < 16; ++r) {
        float a = __builtin_amdgcn_exp2f(p0[r] - c0[r]), c = __builtin_amdgcn_exp2f(p1[r] - c1[r]);
        if (DIAG) { const int key = keybase + (r & 3) + 8 * (r >> 2); a = (key < q) ? a : 0.f; c = (key + 32 < q) ? c : 0.f; }
        s0[r] = a; s1[r] = c;
    }
    carry = __shfl(c0[0], lane & 31);
    const bf16x8v a00 = pack8(s0, 0), a01 = pack8(s0, 8), a10 = pack8(s1, 0), a11 = pack8(s1, 8);
#pragma unroll
    for (int db = 0; db < 2; ++db) {
        const LAS unsigned char* vb = Vt + voff[db];
        s16x4v lo[4], hi[4];
#pragma unroll
        for (int ks = 0; ks < 4; ++ks) { lo[ks] = vtr(vb + ks * 2048); hi[ks] = vtr(vb + ks * 2048 + 1024); }
#define VF(k) (bf16x8v){lo[k][0], lo[k][1], lo[k][2], lo[k][3], hi[k][0], hi[k][1], hi[k][2], hi[k][3]}
        o[db] = __builtin_amdgcn_mfma_f32_32x32x16_bf16(VF(0), a00, o[db], 0, 0, 0);
        o[db] = __builtin_amdgcn_mfma_f32_32x32x16_bf16(VF(1), a01, o[db], 0, 0, 0);
        o[db] = __builtin_amdgcn_mfma_f32_32x32x16_bf16(VF(2), a10, o[db], 0, 0, 0);
        o[db] = __builtin_amdgcn_mfma_f32_32x32x16_bf16(VF(3), a11, o[db], 0, 0, 0);
#undef VF
    }
}
__device__ __forceinline__ void op_attn(const Ctx& C, const Op& op) {
    const __attribute__((address_space(1))) bf16* QKV = (const __attribute__((address_space(1))) bf16*)(C.ws + (size_t)R_BIG * MiB);
    __attribute__((address_space(1))) bf16* O = (__attribute__((address_space(1))) bf16*)(C.ws + (size_t)R_XN * MiB);
    const int lane = C.lane, r = lane & 31, hh = lane >> 5, w = C.wave;
    LAS unsigned char* Kb = C.lds; LAS unsigned char* Vb = C.lds + 16384; volatile LAS int* flags = (volatile LAS int*)(C.lds + 32768);
    int koff[4], voff[2];
#pragma unroll
    for (int d0 = 0; d0 < 4; ++d0) koff[d0] = r * 128 + (((2 * d0 + hh) ^ ((r >> 1) & 7)) << 4);
    { const int i4 = (lane & 15) >> 2, cpart = 2 * ((lane >> 4) & 1) + ((lane & 3) >> 1), swzv = ((i4 >> 1) & 1) << 2;
#pragma unroll
      for (int db = 0; db < 2; ++db) voff[db] = (4 * hh + i4) * 128 + ((((4 * db + cpart) ^ swzv)) << 4) + 8 * (lane & 1); }
    bf16x8v tri[2];
#pragma unroll
    for (int s = 0; s < 2; ++s) { u32x4v t;
        unsigned e[8];
#pragma unroll
        for (int jj = 0; jj < 8; ++jj) e[jj] = ((16 * s + 8 * (jj >> 2) + 4 * hh + (jj & 3)) >= r) ? 0x3f80u : 0u;
        t.x = e[0] | (e[1] << 16); t.y = e[2] | (e[3] << 16); t.z = e[4] | (e[5] << 16); t.w = e[6] | (e[7] << 16); tri[s] = __builtin_bit_cast(bf16x8v, t); }
    const int lkey = C.tid >> 3, lc16 = C.tid & 7;
    const int kdst = lkey * 128 + ((lc16 ^ ((lkey >> 1) & 7)) << 4), vdst = lkey * 128 + ((lc16 ^ (((lkey >> 1) & 1) << 2)) << 4);
#pragma unroll 1
    for (int unit = C.bid; unit < BATCH * CH * 8; unit += C.G) {
        const int ui = unit >> 8, v = unit & 255, bh = v >> 1, half = v & 1;
        const int qb = (ui == 0) ? 2 * half : (ui == 1) ? 7 - 2 * half : (ui == 2) ? 2 * half + 1 : 6 - 2 * half;
        const int b = bh >> 4, h = bh & 15, q0 = qb * 256, q = q0 + 32 * w + r;
        const size_t mrow0 = (size_t)b * SEQ;
        bf16x8v qf[4];
#pragma unroll
        for (int d0 = 0; d0 < 4; ++d0) { const u32x4v x = *(const gu32x4v*)(QKV + (mrow0 + q) * 3072 + h * 64 + 16 * d0 + 8 * hh);
            u32x4v y; y.x = cvtpk(bf2f(x.x & 0xffffu) * AT_C2, bf2f(x.x >> 16) * AT_C2); y.y = cvtpk(bf2f(x.y & 0xffffu) * AT_C2, bf2f(x.y >> 16) * AT_C2);
            y.z = cvtpk(bf2f(x.z & 0xffffu) * AT_C2, bf2f(x.z >> 16) * AT_C2); y.w = cvtpk(bf2f(x.w & 0xffffu) * AT_C2, bf2f(x.w >> 16) * AT_C2); qf[d0] = __builtin_bit_cast(bf16x8v, y); }
        f32x16 o[2]; o[0] = f32x16{}; o[1] = f32x16{};
        float carry = 0.f;
        const int ktmax = 4 * qb + 3, myktmax = 4 * qb + (w >> 1);
        const __attribute__((address_space(1))) bf16* kvsrc = QKV + (mrow0 + lkey) * 3072 + 1024 + h * 64 + lc16 * 8;
        __syncthreads();
        { const u32x4v kr = *(const gu32x4v*)(kvsrc + (size_t)ktmax * 64 * 3072), vr = *(const gu32x4v*)(kvsrc + (size_t)ktmax * 64 * 3072 + 1024);
          *(LAS u32x4v*)(Kb + kdst) = kr; *(LAS u32x4v*)(Vb + vdst) = vr; }
        if (C.tid < 16) flags[C.tid] = 0;
        __syncthreads();
        bool wdone = false;
#pragma unroll 1
        for (int kt = ktmax; kt >= 0; --kt) {
            const int cur = (ktmax - kt) & 1;
            u32x4v kr = {}, vr = {};
            if (kt > 0) { kr = *(const gu32x4v*)(kvsrc + (size_t)(kt - 1) * 64 * 3072); vr = *(const gu32x4v*)(kvsrc + (size_t)(kt - 1) * 64 * 3072 + 1024); }
            if (kt <= myktmax && !wdone) {
                if (kt * 64 + 63 >= q0 + 32 * w) attn_tile<true>(o, carry, qf, tri, Kb + cur * 8192, Vb + cur * 8192, koff, voff, kt * 64 + 4 * hh, q, lane);
                else attn_tile<false>(o, carry, qf, tri, Kb + cur * 8192, Vb + cur * 8192, koff, voff, kt * 64 + 4 * hh, q, lane);
#if AT_EARLY
                wdone = __all(carry > AT_THR) != 0;
#endif
            }
            if (kt > 0) { *(LAS u32x4v*)(Kb + (cur ^ 1) * 8192 + kdst) = kr; *(LAS u32x4v*)(Vb + (cur ^ 1) * 8192 + vdst) = vr; }
#if AT_EARLY
            if (lane == 0) flags[cur * 8 + w] = wdone ? 1 : 0;
#endif
            __syncthreads();
#if AT_EARLY
            { int alld = 1;
#pragma unroll
              for (int i = 0; i < 8; ++i) alld &= flags[cur * 8 + i];
              if (alld) break; }
#endif
        }
        __attribute__((address_space(1))) bf16* orow = O + (mrow0 + q) * DM + h * 64 + 4 * hh;
#pragma unroll
        for (int db = 0; db < 2; ++db)
#pragma unroll
            for (int g = 0; g < 4; ++g) { u32x2v wv; wv.x = cvtpk(o[db][4 * g], o[db][4 * g + 1]); wv.y = cvtpk(o[db][4 * g + 2], o[db][4 * g + 3]); *(gu32x2v*)(orow + 32 * db + 8 * g) = wv; }
    }
}

constexpr int LDS_BYTES = 147456;
#define GAS __attribute__((address_space(1)))
typedef GAS unsigned gu32;
constexpr int CW_BAR = 4096;
#define XB_TMO      128
#define XB_XCNT(j)  (256  + 64 * (j))
#define XB_XSUB(j)  (1280 + 64 * (j))
#define XB_XGEN(j)  (2304 + 64 * (j))
#define XB_TOP      3328
#define XB_TOPGEN   3392
#define XCD_BAR_WORDS 3456
#define XB_SPIN_CAP (1u << 18)

__device__ __forceinline__ unsigned xb_ld(unsigned* p)              { return __hip_atomic_load(p, __ATOMIC_RELAXED, __HIP_MEMORY_SCOPE_AGENT); }
__device__ __forceinline__ unsigned xb_add(unsigned* p, unsigned v) { return __hip_atomic_fetch_add(p, v, __ATOMIC_RELAXED, __HIP_MEMORY_SCOPE_AGENT); }
__device__ __forceinline__ unsigned xb_xcc_id() { return (unsigned)__builtin_amdgcn_s_getreg((3 << 11) | 20) & 0xFu; }
#define XB_SPIN(cond, bar) do { unsigned _sp = 0; while (cond) { __builtin_amdgcn_s_sleep(1); \
    if ((++_sp & 255u) == 0u) { if (xb_ld(&(bar)[XB_TMO])) break; if (_sp > XB_SPIN_CAP) { atomicAdd(&(bar)[XB_TMO], 1u); break; } } } } while (0)

struct XcdBarrier {
    unsigned* bar; unsigned x;
    volatile LAS unsigned* st;
};

__device__ __forceinline__ XcdBarrier xcd_barrier_post(unsigned* bar, volatile LAS unsigned* st) {
    XcdBarrier b; b.bar = bar; b.x = xb_xcc_id(); b.st = st;
    if (threadIdx.x == 0) (void)xb_add(&bar[XB_XCNT(b.x)], 1u);
    return b;
}
__device__ __forceinline__ void xcd_barrier_complete(unsigned* bar, unsigned x, unsigned& nloc, unsigned& nx) {
    const unsigned G = gridDim.x * gridDim.y * gridDim.z;
    unsigned sum, cnt, mine, sp = 0u;
    for (;;) {
        sum = 0u; cnt = 0u; mine = 0u;
#pragma unroll
        for (unsigned j = 0; j < 16; ++j) { const unsigned c = xb_ld(&bar[XB_XCNT(j)]); sum += c; cnt += (c > 0u) ? 1u : 0u; mine = (j == x) ? c : mine; }
        if (sum == G) break;
        __builtin_amdgcn_s_sleep(1);
        if ((++sp & 255u) == 0u) { if (xb_ld(&bar[XB_TMO])) break; if (sp > XB_SPIN_CAP) { atomicAdd(&bar[XB_TMO], 1u); break; } }
    }
    nloc = mine > 0u ? mine : 1u; nx = cnt > 0u ? cnt : 1u;
}

__device__ __forceinline__ void xcd_barrier(const XcdBarrier& b) {
    asm volatile("s_waitcnt vmcnt(0)" ::: "memory");
    __syncthreads();
    if (threadIdx.x == 0) {
        unsigned* bar = b.bar;
        __builtin_amdgcn_s_waitcnt(0);
        unsigned nloc = b.st[0], nx = b.st[1];
        if (nloc == 0u) { xcd_barrier_complete(bar, b.x, nloc, nx); b.st[0] = nloc; b.st[1] = nx; }
        const unsigned old = xb_add(&bar[XB_XSUB(b.x)], 1u);
        const unsigned gen = old / nloc;
        if (old + 1u == (gen + 1u) * nloc) {
            __builtin_amdgcn_fence(__ATOMIC_RELEASE, "agent");
            asm volatile("s_waitcnt vmcnt(0)" ::: "memory");
            const unsigned og = xb_add(&bar[XB_TOP], 1u);
            const unsigned tg = og / nx;
            if (og + 1u == (tg + 1u) * nx) xb_add(&bar[XB_TOPGEN], 1u);
            else XB_SPIN(xb_ld(&bar[XB_TOPGEN]) == tg, bar);
            __builtin_amdgcn_fence(__ATOMIC_ACQUIRE, "agent");
            xb_add(&bar[XB_XGEN(b.x)], 1u);
            asm volatile("s_waitcnt vmcnt(0)" ::: "memory");
        } else {
            XB_SPIN(xb_ld(&bar[XB_XGEN(b.x)]) == gen, bar);
            __builtin_amdgcn_fence(__ATOMIC_ACQUIRE, "agent");
            asm volatile("s_waitcnt vmcnt(0)" ::: "memory");
        }
    }
    __syncthreads();
}


namespace cg = cooperative_groups;
__global__ void __launch_bounds__(NTHREADS, 2) mk_fwd(Args args) {
    extern __shared__ __attribute__((aligned(16))) unsigned char lds[];
    LAS unsigned char* L = (LAS unsigned char*)lds;
    for (int u = threadIdx.x; u < (LDS_BYTES - LDSCTL_OFF) / 4; u += NTHREADS) ((LAS unsigned*)(L + LDSCTL_OFF))[u] = 0u;
    __syncthreads();
    if (threadIdx.x < 43) ((LAS unsigned long long*)(L + INTAB_OFF))[threadIdx.x] = (unsigned long long)args.in[threadIdx.x];
    __syncthreads();
    XcdBarrier bar = xcd_barrier_post((unsigned*)(args.ws + WS_CTL) + CW_BAR, (volatile LAS unsigned*)(L + MISC_OFF) + 8);
    cg::this_grid().sync();
#pragma unroll 1
    for (int oi = args.op_lo; oi < args.op_hi; ++oi) {
        const Op op = args.ops[oi];
        Ctx C;
        { int t = threadIdx.x; asm volatile("" : "+v"(t)); unsigned char* w = args.ws; asm volatile("" : "+s"(w)); float* xo = args.out; asm volatile("" : "+s"(xo));
          C.tid = t; C.lane = t & 63; C.wave = __builtin_amdgcn_readfirstlane(t >> 6); C.ws = w; C.xres = xo; C.G = gridDim.x; C.bid = blockIdx.x;
          C.lds = L; C.in.t = (LAS const unsigned long long*)(L + INTAB_OFF); }
        switch (op.kind) {
            case OP_CONV: op_conv(C); break;
            case OP_ROWS: op_rows(C, op); break;
            case OP_GEMM: op_gemm(C, op); break;
            case OP_PREP: op_prep(C, op); break;
            case OP_SCAN: op_scan(C, op); break;
            case OP_POST: op_post(C, op); break;
            case OP_ATTN: op_attn(C, op); break;
        }
        if (oi + 1 < args.op_hi) xcd_barrier(bar);
    }
}

static int build_ops(Op* ops) {
    int n = 0;
    auto add = [&](int kind, int a = 0, int b = 0, int c = 0, int d = 0, int e = 0, int f = 0, int g = 0) { ops[n++] = Op{kind, a, b, c, d, e, f, g}; };
    auto ffn = [&](int w1, int w2, int gpost, int gpre_next) {
        add(OP_GEMM, R_XN, w1, 2 * DFF, DM, EPI_SWIGLU, R_BIG, DFF);
        add(OP_GEMM, R_BIG, w2, DM, DFF, EPI_F32, R_XN, DM);
        add(OP_ROWS, RM_RES, R_XN, 1, gpost, 0);
        if (gpre_next >= 0) add(OP_ROWS, RM_NORM, 0, 0, 0, gpre_next);
    };
    add(OP_CONV);
    add(OP_ROWS, RM_COPY | RM_NORM, 0, 0, 0, 1);
    ffn(W_L0F1_1, W_L0F1_2, 2, 5);
    add(OP_GEMM, R_XN, W_L0_IN, INPROJ, DM, EPI_B16, R_BIG, INPROJ);
    for (int c = 0; c < NCHUNK; ++c) { add(OP_PREP, c); add(OP_SCAN, c); add(OP_POST, c); }
    add(OP_GEMM, R_XN, W_L0_OUT, DM, DM, EPI_F32, R_BIG, DM);
    add(OP_ROWS, RM_RES | RM_NORM, R_BIG, 2, 6, 27);
    ffn(W_L0F2_1, W_L0F2_2, 28, 31);
    ffn(W_L1F1_1, W_L1F1_2, 32, 35);
    add(OP_GEMM, R_XN, W_L1_QKV, 3 * DM, DM, EPI_B16, R_BIG, 3 * DM);
    add(OP_ATTN);
    add(OP_GEMM, R_XN, W_L1_OUT, DM, DM, EPI_F32, R_BIG, DM);
    add(OP_ROWS, RM_RES | RM_NORM, R_BIG, 2, 36, 39);
    ffn(W_L1F2_1, W_L1F2_2, 40, -1);
    return n;
}

extern "C" void kernel_launch(void* const* d_in, const int* in_sizes, int n_in, void* d_out, int out_size, void* d_ws, size_t ws_size, hipStream_t stream) {
    static int grid = 0;
    if (grid == 0) {
        if (n_in != 43 || in_sizes[0] != MTOK * DM || out_size != MTOK * DM || ws_size < (size_t)R_END * MiB) { fprintf(stderr, "kernel_launch: unexpected shapes (n_in %d, in0 %d, out %d, ws %zu)\n", n_in, n_in > 0 ? in_sizes[0] : -1, out_size, ws_size); grid = -1; return; }
        if (hipFuncSetAttribute((const void*)mk_fwd, hipFuncAttributeMaxDynamicSharedMemorySize, LDS_BYTES) != hipSuccess) { fprintf(stderr, "kernel_launch: hipFuncSetAttribute failed\n"); grid = -1; return; }
        int dev = 0, cus = 0, per_cu = 0;
        if (hipGetDevice(&dev) != hipSuccess || hipDeviceGetAttribute(&cus, hipDeviceAttributeMultiprocessorCount, dev) != hipSuccess) { grid = -1; return; }
        if (hipOccupancyMaxActiveBlocksPerMultiprocessor(&per_cu, (const void*)mk_fwd, NTHREADS, LDS_BYTES) != hipSuccess || per_cu < 1) { fprintf(stderr, "kernel_launch: occupancy query failed (%d)\n", per_cu); grid = -1; return; }
        grid = cus * per_cu;
    }
    if (grid < 0) return;
    if (hipMemsetAsync((char*)d_ws + WS_CTL, 0, CTL_ZERO_BYTES, stream) != hipSuccess) { fprintf(stderr, "kernel_launch: hipMemsetAsync failed\n"); return; }
    Args a{};
    for (int i = 0; i < 43; ++i) a.in[i] = (const float*)d_in[i];
    a.out = (float*)d_out; a.ws = (unsigned char*)d_ws;
    const int nops = build_ops(a.ops);
    a.op_lo = 0; a.op_hi = nops;
    void* kargs[] = {&a};
    const hipError_t e = hipLaunchCooperativeKernel((const void*)mk_fwd, dim3(grid), dim3(NTHREADS), kargs, LDS_BYTES, stream);
    if (e != hipSuccess) fprintf(stderr, "kernel_launch: cooperative launch failed: %s (grid %d)\n", hipGetErrorString(e), grid);
}
```
